# Optimizing an MI355X kernel written in HIP

```python
import math
import jax, jax.numpy as jnp
from jax import lax
import numpy as np

D_MODEL = 1024
BATCH = 8
SEQ = 2048
DEPTH = 1
DEC_BATCH = 128
DEC_SEQ = 4
PAST_LEN = 2048
PAGE_SIZE = 128

N_ATT_HEADS = 8
ATT_HEAD_DIM = 64
D_ATT = N_ATT_HEADS * ATT_HEAD_DIM
DILATED_CFGS = ((128, 1), (512, 4), (2048, 16))
WIN_MAX = 2048
SSM_CH = 16
D_SSM = D_MODEL - D_ATT
N_SSM_GROUPS = D_SSM // SSM_CH
SSM_STATE = 64
D_IN = 3 * D_ATT + D_SSM
N_MEM = 256
MEM_HEADS = 4
MEM_HEAD_DIM = D_MODEL // MEM_HEADS
D_FF = -(-8 * D_MODEL // (3 * 256)) * 256
DEEPNORM_ALPHA = (2 * DEPTH) ** 0.25
DEEPNORM_BETA = (8 * DEPTH) ** -0.25
EPS = 1e-5
NEG = -1e30

kernel_name = "hymba_s5_longnet_memxattn_deepnorm_step"


def layer_norm(x, g, b):
    xf = x.astype(jnp.float32)
    mu = jnp.mean(xf, -1, keepdims=True)
    var = jnp.mean(jnp.square(xf - mu), -1, keepdims=True)
    return ((xf - mu) * lax.rsqrt(var + EPS) * g + b).astype(x.dtype)


def rms_norm(x, g):
    xf = x.astype(jnp.float32)
    return (xf * lax.rsqrt(jnp.mean(jnp.square(xf), -1, keepdims=True) + EPS) * g).astype(x.dtype)


def combine_by_denominators(outs, lses):
    lse = jnp.stack(lses, 0)
    w = jnp.exp(lse - jax.nn.logsumexp(lse, axis=0, keepdims=True))
    return jnp.sum(w[..., None] * jnp.stack(outs, 0), axis=0)


def dilated_attention_prompt(q, k, v):
    B, S, H, dh = q.shape
    scale = dh ** -0.5
    outs, lses = [], []
    for window, d in DILATED_CFGS:
        reach = window // d
        blk = reach
        span = d * blk
        Sp = -(-S // span) * span
        L = Sp // d
        nb = L // blk
        pad = ((0, 0), (0, Sp - S), (0, 0), (0, 0))

        def to_blocks(t):
            t = jnp.pad(t, pad).reshape(B, L, d, H, dh).transpose(0, 2, 1, 3, 4)
            return t.reshape(B, d, nb, blk, H, dh)

        qb, kb, vb = to_blocks(q), to_blocks(k), to_blocks(v)
        shift = ((0, 0), (0, 0), (1, 0), (0, 0), (0, 0), (0, 0))
        kk = jnp.concatenate([jnp.pad(kb, shift)[:, :, :-1], kb], axis=3)
        vv = jnp.concatenate([jnp.pad(vb, shift)[:, :, :-1], vb], axis=3)
        s = jnp.einsum("brnqhd,brnkhd->brnhqk", qb, kk).astype(jnp.float32) * scale
        qi = jnp.arange(blk)[:, None]
        kj = jnp.arange(2 * blk)[None, :]
        dist = qi + blk - kj
        band = (dist >= 0) & (dist <= reach)
        real = (jnp.arange(nb)[:, None, None] > 0) | (kj[None] >= blk)
        valid = (band[None] & real)[:, None]
        s = jnp.where(valid, s, NEG)
        m = jnp.max(s, -1, keepdims=True)
        p = jnp.exp(s - m)
        den = jnp.sum(p, -1, keepdims=True)
        o = jnp.einsum("brnhqk,brnkhd->brnqhd", p, vv.astype(jnp.float32))
        o = o / jnp.transpose(den, (0, 1, 2, 4, 3, 5))
        lse = (m + jnp.log(den))[..., 0]
        o = o.reshape(B, d, L, H, dh).transpose(0, 2, 1, 3, 4).reshape(B, Sp, H, dh)[:, :S]
        lse = lse.transpose(0, 1, 2, 4, 3).reshape(B, d, L, H).transpose(0, 2, 1, 3).reshape(B, Sp, H)[:, :S]
        outs.append(o)
        lses.append(lse)
    return combine_by_denominators(outs, lses).astype(q.dtype)


def dilated_attention_sample(q, k, v, cache_k, cache_v):
    W = cache_k.shape[1]
    T = q.shape[1]
    scale = q.shape[-1] ** -0.5
    kk = jnp.concatenate([cache_k.astype(k.dtype), k], axis=1)
    vv = jnp.concatenate([cache_v.astype(v.dtype), v], axis=1)
    outs, lses = [], []
    for window, d in DILATED_CFGS:
        steps = jnp.arange(window // d + 1)
        idx = W + jnp.arange(T)[:, None] - steps[None, :] * d
        valid = idx >= 0
        idxc = jnp.maximum(idx, 0)
        kg, vg = kk[:, idxc], vv[:, idxc]
        s = jnp.einsum("bthd,btmhd->bhtm", q, kg).astype(jnp.float32) * scale
        s = jnp.where(valid[None, None], s, NEG)
        m = jnp.max(s, -1, keepdims=True)
        p = jnp.exp(s - m)
        den = jnp.sum(p, -1, keepdims=True)
        o = jnp.einsum("bhtm,btmhd->bthd", p, vg.astype(jnp.float32))
        o = o / jnp.transpose(den, (0, 2, 1, 3))
        lse = jnp.transpose((m + jnp.log(den))[..., 0], (0, 2, 1))
        outs.append(o)
        lses.append(lse)
    return combine_by_denominators(outs, lses).astype(q.dtype)


def s5_mixer(u, h0_re, h0_im, a_re, a_im, log_dt, b_re, b_im, c_re, c_im, d_skip, w_glu, b_glu):
    Bn, L, _ = u.shape
    uf = u.astype(jnp.float32).reshape(Bn, L, N_SSM_GROUPS, SSM_CH)
    dt = jnp.exp(log_dt.astype(jnp.float32))[:, None]
    ar, ai = a_re.astype(jnp.float32), a_im.astype(jnp.float32)
    mag = jnp.exp(dt * ar)
    abar_re, abar_im = mag * jnp.cos(dt * ai), mag * jnp.sin(dt * ai)
    den = ar * ar + ai * ai
    nr, ni = abar_re - 1.0, abar_im
    coef_re = (nr * ar + ni * ai) / den
    coef_im = (ni * ar - nr * ai) / den
    br, bi = b_re.astype(jnp.float32), b_im.astype(jnp.float32)
    bbar_re = coef_re[..., None] * br - coef_im[..., None] * bi
    bbar_im = coef_re[..., None] * bi + coef_im[..., None] * br
    bu_re = jnp.einsum("blgh,gph->blgp", uf, bbar_re)
    bu_im = jnp.einsum("blgh,gph->blgp", uf, bbar_im)
    h0r, h0i = h0_re.astype(jnp.float32), h0_im.astype(jnp.float32)
    bu_re = bu_re.at[:, 0].add(abar_re * h0r - abar_im * h0i)
    bu_im = bu_im.at[:, 0].add(abar_re * h0i + abar_im * h0r)
    a_full_re = jnp.broadcast_to(abar_re, bu_re.shape)
    a_full_im = jnp.broadcast_to(abar_im, bu_im.shape)

    def combine(e1, e2):
        a1r, a1i, b1r, b1i = e1
        a2r, a2i, b2r, b2i = e2
        return (a2r * a1r - a2i * a1i, a2r * a1i + a2i * a1r,
                a2r * b1r - a2i * b1i + b2r, a2r * b1i + a2i * b1r + b2i)

    _, _, hr, hi = lax.associative_scan(combine, (a_full_re, a_full_im, bu_re, bu_im), axis=1)
    y = (jnp.einsum("ghp,blgp->blgh", c_re.astype(jnp.float32), hr)
         - jnp.einsum("ghp,blgp->blgh", c_im.astype(jnp.float32), hi)
         + d_skip.astype(jnp.float32) * uf).reshape(Bn, L, D_SSM)
    g = jax.nn.gelu(y)
    out = g * jax.nn.sigmoid(g @ w_glu.astype(jnp.float32) + b_glu.astype(jnp.float32))
    return out.astype(u.dtype), hr[:, -1], hi[:, -1]


def memory_attention(x, mem_k, mem_v, w_mem_q, w_mem_o):
    Bn, L, _ = x.shape
    q = (x @ w_mem_q).reshape(Bn, L, MEM_HEADS, MEM_HEAD_DIM)
    s = jnp.einsum("blhd,bmhd->bhlm", q, mem_k.astype(q.dtype)).astype(jnp.float32) * MEM_HEAD_DIM ** -0.5
    p = jax.nn.softmax(s, axis=-1)
    o = jnp.einsum("bhlm,bmhd->blhd", p, mem_v.astype(jnp.float32)).astype(x.dtype)
    return o.reshape(Bn, L, D_MODEL) @ w_mem_o


def trunk_layer(x, h0_re, h0_im, mem_k, mem_v, attend,
                w_in, g_att, g_ssm, a_re, a_im, log_dt, b_re, b_im, c_re, c_im, d_skip, w_glu, b_glu, w_out,
                ln1_g, ln1_b, w_mem_q, w_mem_o, ln2_g, ln2_b, w_gate, w_up, w_down, ln3_g, ln3_b):
    Bn, L, _ = x.shape
    proj = x @ w_in
    q, k, v, u = jnp.split(proj, [D_ATT, 2 * D_ATT, 3 * D_ATT], axis=-1)
    q = q.reshape(Bn, L, N_ATT_HEADS, ATT_HEAD_DIM)
    k = k.reshape(Bn, L, N_ATT_HEADS, ATT_HEAD_DIM)
    v = v.reshape(Bn, L, N_ATT_HEADS, ATT_HEAD_DIM)
    o_att = attend(q, k, v).reshape(Bn, L, D_ATT)
    y_ssm, h_re, h_im = s5_mixer(u, h0_re, h0_im, a_re, a_im, log_dt, b_re, b_im, c_re, c_im, d_skip, w_glu, b_glu)
    mixed = jnp.concatenate([rms_norm(o_att, g_att), rms_norm(y_ssm, g_ssm)], axis=-1) @ w_out
    x = layer_norm(DEEPNORM_ALPHA * x + mixed, ln1_g, ln1_b)
    x = layer_norm(DEEPNORM_ALPHA * x + memory_attention(x, mem_k, mem_v, w_mem_q, w_mem_o), ln2_g, ln2_b)
    ffn = (jax.nn.silu(x @ w_gate) * (x @ w_up)) @ w_down
    x = layer_norm(DEEPNORM_ALPHA * x + ffn, ln3_g, ln3_b)
    return x, k, v, h_re, h_im


def setup_inputs(seed: int = 0) -> dict:
    key = jax.random.key(seed)
    ks = iter(jax.random.split(key, 64))
    f32 = jnp.float32

    def nrm(shape, scale=1.0):
        return scale * jax.random.normal(next(ks), shape, f32)

    w_buf = min(WIN_MAX, PAST_LEN)
    G, P = N_SSM_GROUPS, SSM_STATE
    n = jnp.arange(P, dtype=f32)
    return {
        "x_prompt": nrm((BATCH, SEQ, D_MODEL)),
        "x_sample": nrm((DEC_BATCH, DEC_SEQ, D_MODEL)),
        "cache_win_k": nrm((DEPTH, DEC_BATCH, w_buf, N_ATT_HEADS, ATT_HEAD_DIM)),
        "cache_win_v": nrm((DEPTH, DEC_BATCH, w_buf, N_ATT_HEADS, ATT_HEAD_DIM)),
        "state_ssm_re": nrm((DEPTH, DEC_BATCH, G, P), 0.3),
        "state_ssm_im": nrm((DEPTH, DEC_BATCH, G, P), 0.3),
        "cache_mem_k": nrm((DEPTH, DEC_BATCH, N_MEM, MEM_HEADS, MEM_HEAD_DIM)),
        "cache_mem_v": nrm((DEPTH, DEC_BATCH, N_MEM, MEM_HEADS, MEM_HEAD_DIM)),
        "mem_prompt": nrm((BATCH, N_MEM, D_MODEL)),
        "w_in": nrm((DEPTH, D_MODEL, D_IN), D_MODEL ** -0.5),
        "g_att": 1.0 + nrm((DEPTH, D_ATT), 0.01),
        "g_ssm": 1.0 + nrm((DEPTH, D_SSM), 0.01),
        "ssm_a_re": -0.5 * jnp.exp(nrm((DEPTH, G, P), 0.05)),
        "ssm_a_im": math.pi * n + nrm((DEPTH, G, P), 0.01),
        "ssm_log_dt": jax.random.uniform(next(ks), (DEPTH, G), f32, math.log(1e-3), math.log(1e-1)),
        "ssm_b_re": nrm((DEPTH, G, P, SSM_CH), (2 * SSM_CH) ** -0.5),
        "ssm_b_im": nrm((DEPTH, G, P, SSM_CH), (2 * SSM_CH) ** -0.5),
        "ssm_c_re": nrm((DEPTH, G, SSM_CH, P), (2 * P) ** -0.5),
        "ssm_c_im": nrm((DEPTH, G, SSM_CH, P), (2 * P) ** -0.5),
        "ssm_d": nrm((DEPTH, G, SSM_CH)),
        "w_glu": nrm((DEPTH, D_SSM, D_SSM), D_SSM ** -0.5),
        "b_glu": nrm((DEPTH, D_SSM), 0.02),
        "w_out": nrm((DEPTH, D_ATT + D_SSM, D_MODEL), (D_ATT + D_SSM) ** -0.5 * DEEPNORM_BETA),
        "ln1_g": 1.0 + nrm((DEPTH, D_MODEL), 0.01),
        "ln1_b": nrm((DEPTH, D_MODEL), 0.01),
        "w_mem_q": nrm((DEPTH, D_MODEL, D_MODEL), D_MODEL ** -0.5),
        "w_mem_k": nrm((DEPTH, D_MODEL, D_MODEL), D_MODEL ** -0.5),
        "w_mem_v": nrm((DEPTH, D_MODEL, D_MODEL), D_MODEL ** -0.5),
        "w_mem_o": nrm((DEPTH, D_MODEL, D_MODEL), D_MODEL ** -0.5 * DEEPNORM_BETA),
        "ln2_g": 1.0 + nrm((DEPTH, D_MODEL), 0.01),
        "ln2_b": nrm((DEPTH, D_MODEL), 0.01),
        "w_gate": nrm((DEPTH, D_MODEL, D_FF), D_MODEL ** -0.5),
        "w_up": nrm((DEPTH, D_MODEL, D_FF), D_MODEL ** -0.5),
        "w_down": nrm((DEPTH, D_FF, D_MODEL), D_FF ** -0.5 * DEEPNORM_BETA),
        "ln3_g": 1.0 + nrm((DEPTH, D_MODEL), 0.01),
        "ln3_b": nrm((DEPTH, D_MODEL), 0.01),
    }


def reference(x_prompt, x_sample, cache_win_k, cache_win_v, state_ssm_re, state_ssm_im, cache_mem_k, cache_mem_v,
              mem_prompt, w_in, g_att, g_ssm, ssm_a_re, ssm_a_im, ssm_log_dt, ssm_b_re, ssm_b_im, ssm_c_re, ssm_c_im,
              ssm_d, w_glu, b_glu, w_out, ln1_g, ln1_b, w_mem_q, w_mem_k, w_mem_v, w_mem_o, ln2_g, ln2_b,
              w_gate, w_up, w_down, ln3_g, ln3_b):
    Bp, S, _ = x_prompt.shape
    keep = min(WIN_MAX, S)
    y_p, y_s = x_prompt, x_sample
    wk_p, wv_p, wk_s, wv_s = [], [], [], []
    hr_p, hi_p, hr_s, hi_s = [], [], [], []
    mk_p, mv_p = [], []
    for l in range(DEPTH):
        lw = (w_in[l], g_att[l], g_ssm[l], ssm_a_re[l], ssm_a_im[l], ssm_log_dt[l], ssm_b_re[l], ssm_b_im[l],
              ssm_c_re[l], ssm_c_im[l], ssm_d[l], w_glu[l], b_glu[l], w_out[l], ln1_g[l], ln1_b[l],
              w_mem_q[l], w_mem_o[l], ln2_g[l], ln2_b[l], w_gate[l], w_up[l], w_down[l], ln3_g[l], ln3_b[l])
        mem_k = (mem_prompt @ w_mem_k[l]).reshape(Bp, N_MEM, MEM_HEADS, MEM_HEAD_DIM)
        mem_v = (mem_prompt @ w_mem_v[l]).reshape(Bp, N_MEM, MEM_HEADS, MEM_HEAD_DIM)
        h0 = jnp.zeros((Bp, N_SSM_GROUPS, SSM_STATE), jnp.float32)
        y_p, k_p, v_p, h_re_p, h_im_p = trunk_layer(y_p, h0, h0, mem_k, mem_v, dilated_attention_prompt, *lw)
        ck, cv = cache_win_k[l], cache_win_v[l]
        attend_s = lambda q, k, v, ck=ck, cv=cv: dilated_attention_sample(q, k, v, ck, cv)
        y_s, k_s, v_s, h_re_s, h_im_s = trunk_layer(y_s, state_ssm_re[l], state_ssm_im[l],
                                                    cache_mem_k[l], cache_mem_v[l], attend_s, *lw)
        wk_p.append(k_p[:, S - keep:])
        wv_p.append(v_p[:, S - keep:])
        wk_s.append(k_s)
        wv_s.append(v_s)
        hr_p.append(h_re_p)
        hi_p.append(h_im_p)
        hr_s.append(h_re_s)
        hi_s.append(h_im_s)
        mk_p.append(mem_k)
        mv_p.append(mem_v)
    return (y_p, y_s,
            jnp.stack(wk_p), jnp.stack(wv_p), jnp.stack(wk_s), jnp.stack(wv_s),
            jnp.stack(hr_p), jnp.stack(hi_p), jnp.stack(hr_s), jnp.stack(hi_s),
            jnp.stack(mk_p), jnp.stack(mv_p))
```

```cpp
#include <hip/hip_runtime.h>
#include <cstdio>
#include <cstdint>
namespace pg8 {
#define PG8_LAS __attribute__((address_space(3)))
typedef unsigned short bf16_t;
typedef short bf16x8 __attribute__((ext_vector_type(8)));
typedef float f32x4 __attribute__((ext_vector_type(4)));
typedef unsigned u32x4 __attribute__((ext_vector_type(4)));
constexpr int BM = 256, BK = 64, HALF = 128, HTB = HALF * BK * 2  , STAGE_BYTES = 8 * HTB, NXCD = 8, WGM = 8;

__host__ __device__ __forceinline__ int lds_byte(int r, int c) { const int st = (r >> 4) * 2 + (c >> 5), rr = r & 15, cc = c & 31, ob = rr * 64 + cc * 2; return st * 1024 + (ob ^ (((ob >> 9) & 1) << 5)); }
__host__ __device__ __forceinline__ void stage_rc(int b, int& R, int& C) { const int st = b / 1024, sb = b % 1024, swz = sb ^ (((sb >> 9) & 1) << 5); R = (st >> 1) * 16 + swz / 64; C = (st & 1) * 32 + (swz % 64) / 2; }
__host__ __device__ __forceinline__ int perm32(int rho) { const int n = rho >> 4, i = rho & 15; return 8 * (i >> 2) + 4 * n + (i & 3); }

struct Unit { int pm, pn; };
struct Gemm { const bf16_t* A; const bf16_t* Bt; int M, N, K; };

struct StaticOrder {
    int nM, nN, nwg, G, c;
    __host__ __device__ void init(int M, int N, int G_, int c_) { nM = M / BM; nN = N / BM; nwg = nM * nN; G = G_; c = c_; }
    __host__ __device__ bool next(int i, Unit& u) const {
        const long L = (long)i * G + c; if (L >= nwg) return false;
        int wgid = (int)L; { const int q = nwg / NXCD, r = nwg % NXCD, xcd = wgid % NXCD, off = wgid / NXCD; wgid = (xcd < r ? xcd * (q + 1) : r * (q + 1) + (xcd - r) * q) + off; }
        const int nig = WGM * nN, gid = wgid / nig, fm = gid * WGM, gsz = (nM - fm) < WGM ? (nM - fm) : WGM;
        u.pm = fm + ((wgid % nig) % gsz); u.pn = (wgid % nig) / gsz; return true;
    }
    __device__ __forceinline__ void a_ready(const Unit&) const {}
    __device__ __forceinline__ void done(const Unit&) const {}
};

__device__ __forceinline__ unsigned cvt_pk_bf16(float lo, float hi) { unsigned r; asm volatile("v_cvt_pk_bf16_f32 %0, %1, %2" : "=v"(r) : "v"(lo), "v"(hi)); return r; }
typedef float f32x2 __attribute__((ext_vector_type(2)));
__device__ __forceinline__ f32x2 gelu_pk(f32x2 v) {
    const f32x2 av = __builtin_elementwise_abs(v), d = av * 0.2316418882f + 1.0f;
    f32x2 t; t.x = __builtin_amdgcn_rcpf(d.x); t.y = __builtin_amdgcn_rcpf(d.y);
    f32x2 q = t * 0.5307027145f + (-0.7265760135f); q = q * t + 0.7107068705f; q = q * t + (-0.142248368f); q = q * t + 0.127414796f; q = q * t;
    const f32x2 s = (v * v) * (-0.72134752044f);
    f32x2 e; e.x = __builtin_amdgcn_exp2f(s.x); e.y = __builtin_amdgcn_exp2f(s.y);
    const f32x2 m = v * (q * e), r = v - m;
    f32x2 o; o.x = v.x < 0.f ? m.x : r.x; o.y = v.y < 0.f ? m.y : r.y; return o;
}

typedef unsigned u32x2 __attribute__((ext_vector_type(2)));
__device__ __forceinline__ float bf_lo(unsigned w) { return __uint_as_float(w << 16); }
__device__ __forceinline__ float bf_hi(unsigned w) { return __uint_as_float(w & 0xffff0000u); }
__device__ __forceinline__ float sigmoidf_(float x) { return __builtin_amdgcn_rcpf(1.0f + __builtin_amdgcn_exp2f(-1.4426950408889634f * x)); }

struct EpiIn {
    static constexpr bool PERM = true, AFTER_DRAIN = false;
    bf16_t *Q, *Kb, *Vb, *U; float *wkp, *wvp, *wks, *wvs; float qscale; int mp;
    __device__ __forceinline__ void operator()(const f32x4 (&acc)[2][2][4][2], const Unit& u, int wr, int wc, int fr, int fq) const {
        const int t = u.pn >> 1, colt = (u.pn & 1) * BM;
        bf16_t* base = t == 0 ? Q : (t == 1 ? Kb : (t == 2 ? Vb : U));
        const float sc = t == 0 ? qscale : 1.f;
        const bool prompt = u.pm * BM < mp;
        float* fo = (t == 1) ? (prompt ? wkp : wks) : ((t == 2) ? (prompt ? wvp : wvs) : nullptr);
        const int row0 = u.pm * BM + wr * 64 + fr, frow0 = prompt ? row0 : row0 - mp, col0 = colt + wc * 32 + 8 * fq;
#pragma unroll
        for (int ai = 0; ai < 2; ++ai)
#pragma unroll
            for (int m = 0; m < 4; ++m) {
                const size_t ro = (size_t)(row0 + ai * HALF + m * 16) * 512 + col0, fro = (size_t)(frow0 + ai * HALF + m * 16) * 512 + col0;
#pragma unroll
                for (int bj = 0; bj < 2; ++bj) {
                    const f32x4 v0 = acc[ai][bj][m][0] * sc, v1 = acc[ai][bj][m][1] * sc;
                    u32x4 w; w.x = cvt_pk_bf16(v0[0], v0[1]); w.y = cvt_pk_bf16(v0[2], v0[3]); w.z = cvt_pk_bf16(v1[0], v1[1]); w.w = cvt_pk_bf16(v1[2], v1[3]);
                    *(u32x4*)(base + ro + bj * HALF) = w;
                    if (fo) { *(f32x4*)(fo + fro + bj * HALF) = v0; *(f32x4*)(fo + fro + bj * HALF + 4) = v1; }
                }
            }
    }
};
struct EpiMkv {
    static constexpr bool PERM = false, AFTER_DRAIN = false;
    float *ko, *vo; bf16_t *kb, *vb;
    __device__ __forceinline__ void operator()(const f32x4 (&acc)[2][2][4][2], const Unit& u, int wr, int wc, int fr, int fq) const {
        const int t = u.pn >> 2, colt = (u.pn & 3) * BM;
        float* fo = t ? vo : ko; bf16_t* bo = t ? vb : kb;
        const int row0 = u.pm * BM + wr * 64 + fr, col0 = colt + wc * 32 + 4 * fq;
#pragma unroll
        for (int ai = 0; ai < 2; ++ai)
#pragma unroll
            for (int m = 0; m < 4; ++m) { const size_t ro = (size_t)(row0 + ai * HALF + m * 16) * 1024 + col0;
#pragma unroll
                for (int bj = 0; bj < 2; ++bj)
#pragma unroll
                    for (int n = 0; n < 2; ++n) { const f32x4 v = acc[ai][bj][m][n]; *(f32x4*)(fo + ro + bj * HALF + n * 16) = v;
                        u32x2 w; w.x = cvt_pk_bf16(v[0], v[1]); w.y = cvt_pk_bf16(v[2], v[3]); *(u32x2*)(bo + ro + bj * HALF + n * 16) = w; } }
    }
};
struct EpiRes {
    static constexpr bool PERM = false, AFTER_DRAIN = false;
    const float *resP, *resS; float* out; float alpha; int mp;
    __device__ __forceinline__ void operator()(const f32x4 (&acc)[2][2][4][2], const Unit& u, int wr, int wc, int fr, int fq) const {
        const bool prompt = u.pm * BM < mp;
        const float* rs = prompt ? resP : resS;
        const int row0 = u.pm * BM + wr * 64 + fr, rrow0 = prompt ? row0 : row0 - mp, col0 = u.pn * BM + wc * 32 + 4 * fq;
#pragma unroll
        for (int ai = 0; ai < 2; ++ai)
#pragma unroll
            for (int m = 0; m < 4; ++m) { const size_t ro = (size_t)(row0 + ai * HALF + m * 16) * 1024 + col0, rro = (size_t)(rrow0 + ai * HALF + m * 16) * 1024 + col0;
#pragma unroll
                for (int bj = 0; bj < 2; ++bj)
#pragma unroll
                    for (int n = 0; n < 2; ++n) { const f32x4 r = *(const f32x4*)(rs + rro + bj * HALF + n * 16); *(f32x4*)(out + ro + bj * HALF + n * 16) = r * alpha + acc[ai][bj][m][n]; } }
    }
};
struct EpiBfS {
    static constexpr bool PERM = true, AFTER_DRAIN = false;
    bf16_t* O; int ldc; float scale;
    __device__ __forceinline__ void operator()(const f32x4 (&acc)[2][2][4][2], const Unit& u, int wr, int wc, int fr, int fq) const {
        const int row0 = u.pm * BM + wr * 64 + fr, col0 = u.pn * BM + wc * 32 + 8 * fq;
#pragma unroll
        for (int ai = 0; ai < 2; ++ai)
#pragma unroll
            for (int m = 0; m < 4; ++m) { bf16_t* rowp = O + (size_t)(row0 + ai * HALF + m * 16) * ldc + col0;
#pragma unroll
                for (int bj = 0; bj < 2; ++bj) { const f32x4 v0 = acc[ai][bj][m][0] * scale, v1 = acc[ai][bj][m][1] * scale;
                    u32x4 w; w.x = cvt_pk_bf16(v0[0], v0[1]); w.y = cvt_pk_bf16(v0[2], v0[3]); w.z = cvt_pk_bf16(v1[0], v1[1]); w.w = cvt_pk_bf16(v1[2], v1[3]);
                    *(u32x4*)(rowp + bj * HALF) = w; } }
    }
};
struct EpiGlu {
    static constexpr bool PERM = true, AFTER_DRAIN = false;
    const bf16_t* Gb; const float* bias; bf16_t* O;
    __device__ __forceinline__ void operator()(const f32x4 (&acc)[2][2][4][2], const Unit& u, int wr, int wc, int fr, int fq) const {
        const int row0 = u.pm * BM + wr * 64 + fr, col0 = u.pn * BM + wc * 32 + 8 * fq;
        f32x4 bv[2][2];
#pragma unroll
        for (int bj = 0; bj < 2; ++bj)
#pragma unroll
            for (int n = 0; n < 2; ++n) bv[bj][n] = *(const f32x4*)(bias + col0 + bj * HALF + 4 * n);
#pragma unroll
        for (int ai = 0; ai < 2; ++ai)
#pragma unroll
            for (int m = 0; m < 4; ++m) { const size_t ro = (size_t)(row0 + ai * HALF + m * 16) * 512 + col0;
#pragma unroll
                for (int bj = 0; bj < 2; ++bj) {
                    const u32x4 gw = *(const u32x4*)(Gb + ro + bj * HALF);
                    const f32x4 z0 = acc[ai][bj][m][0] + bv[bj][0], z1 = acc[ai][bj][m][1] + bv[bj][1];
                    float o[8];
                    o[0] = bf_lo(gw.x) * sigmoidf_(z0[0]); o[1] = bf_hi(gw.x) * sigmoidf_(z0[1]); o[2] = bf_lo(gw.y) * sigmoidf_(z0[2]); o[3] = bf_hi(gw.y) * sigmoidf_(z0[3]);
                    o[4] = bf_lo(gw.z) * sigmoidf_(z1[0]); o[5] = bf_hi(gw.z) * sigmoidf_(z1[1]); o[6] = bf_lo(gw.w) * sigmoidf_(z1[2]); o[7] = bf_hi(gw.w) * sigmoidf_(z1[3]);
                    u32x4 w; w.x = cvt_pk_bf16(o[0], o[1]); w.y = cvt_pk_bf16(o[2], o[3]); w.z = cvt_pk_bf16(o[4], o[5]); w.w = cvt_pk_bf16(o[6], o[7]);
                    *(u32x4*)(O + ro + bj * HALF) = w; } }
    }
};
struct EpiGateUp {
    static constexpr bool PERM = true, AFTER_DRAIN = false;
    bf16_t* H; int ldh;
    __device__ __forceinline__ void operator()(const f32x4 (&acc)[2][2][4][2], const Unit& u, int wr, int wc, int fr, int fq) const {
        const int row0 = u.pm * BM + wr * 64 + fr, col0 = (u.pn * BM + wc * 32 + 8 * fq) >> 1;
#pragma unroll
        for (int ai = 0; ai < 2; ++ai)
#pragma unroll
            for (int m = 0; m < 4; ++m) { bf16_t* rowp = H + (size_t)(row0 + ai * HALF + m * 16) * ldh + col0;
#pragma unroll
                for (int bj = 0; bj < 2; ++bj) { const f32x4 g = acc[ai][bj][m][0], up = acc[ai][bj][m][1];
                    const float h0 = g[0] * sigmoidf_(g[0]) * up[0], h1 = g[1] * sigmoidf_(g[1]) * up[1], h2 = g[2] * sigmoidf_(g[2]) * up[2], h3 = g[3] * sigmoidf_(g[3]) * up[3];
                    u32x2 w; w.x = cvt_pk_bf16(h0, h1); w.y = cvt_pk_bf16(h2, h3);
                    *(u32x2*)(rowp + bj * (HALF / 2)) = w; } }
    }
};
struct PanelStats {
    unsigned* xbuf;
    unsigned* cnt;
    unsigned* tmo;
    int ntn; float eps;
    unsigned code;
    __device__ __forceinline__ bool run(const f32x4 (&v)[2][2][4][2], const Unit& u, int wr, int wc, int fr, int fq, PG8_LAS unsigned char* lds, int wid, int lane) const {
        typedef float f32x2v __attribute__((ext_vector_type(2)));
        PG8_LAS f32x2v* P = (PG8_LAS f32x2v*)lds;
        PG8_LAS f32x2v* S = (PG8_LAS f32x2v*)(lds + 8192);
        PG8_LAS unsigned* flag = (PG8_LAS unsigned*)(lds + 8192 + 2048);
#pragma unroll
        for (int ai = 0; ai < 2; ++ai)
#pragma unroll
            for (int m = 0; m < 4; ++m) {
                float s = 0.f;
#pragma unroll
                for (int bj = 0; bj < 2; ++bj)
#pragma unroll
                    for (int n = 0; n < 2; ++n) { const f32x4 x = v[ai][bj][m][n]; s += (x[0] + x[1]) + (x[2] + x[3]); }
                s += __shfl_xor(s, 16); s += __shfl_xor(s, 32);
                const float mw = s * (1.0f / 64.0f); float q = 0.f;
#pragma unroll
                for (int bj = 0; bj < 2; ++bj)
#pragma unroll
                    for (int n = 0; n < 2; ++n) { const f32x4 d = v[ai][bj][m][n] - mw; q += (d[0] * d[0] + d[1] * d[1]) + (d[2] * d[2] + d[3] * d[3]); }
                q += __shfl_xor(q, 16); q += __shfl_xor(q, 32);
                if (fq == 0) P[(ai * HALF + wr * 64 + m * 16 + fr) * 4 + wc] = (f32x2v){mw, q};
            }
        asm volatile("s_waitcnt lgkmcnt(0)" ::: "memory"); __builtin_amdgcn_s_barrier(); asm volatile("" ::: "memory");
#if defined(BROKEN_EXCHANGE_NO_WAIT)
#warning BROKEN CONTROL BUILD: the row-statistics exchange does not wait; results are wrong by design
        if (blockIdx.x >= 64) { const long long t0_ = clock64(); while (clock64() - t0_ < 60000) __builtin_amdgcn_s_sleep(8); }
#endif
        const int row = wid * 32 + (lane & 31);
        if (lane < 32) {
            const f32x2v a = P[row * 4 + 0], b = P[row * 4 + 1], c = P[row * 4 + 2], d = P[row * 4 + 3];
            const float mt = (a.x + b.x + c.x + d.x) * 0.25f;
            const float da = a.x - mt, db = b.x - mt, dc = c.x - mt, dd = d.x - mt;
            const float m2 = (a.y + b.y) + (c.y + d.y) + 64.0f * ((da * da + db * db) + (dc * dc + dd * dd));
            unsigned long long* slot = (unsigned long long*)xbuf + ((size_t)(u.pm * BM + row) * 4 + u.pn);
            __hip_atomic_store(slot, ((unsigned long long)__float_as_uint(m2) << 32) | __float_as_uint(mt), __ATOMIC_RELAXED, __HIP_MEMORY_SCOPE_AGENT);
        }
        asm volatile("s_waitcnt vmcnt(0)" ::: "memory");
        if (lane == 0) __hip_atomic_fetch_add(cnt + 64 * u.pm, 1u, __ATOMIC_RELAXED, __HIP_MEMORY_SCOPE_AGENT);
        if (wid == 0) {
            bool dead = false; const unsigned long long t0 = __builtin_amdgcn_s_memrealtime(); const unsigned want = 8u * (unsigned)ntn;
            for (;;) {
#if defined(BROKEN_EXCHANGE_NO_WAIT)
                break;
#endif
                if ((unsigned)__builtin_amdgcn_readfirstlane(__hip_atomic_load(cnt + 64 * u.pm, __ATOMIC_RELAXED, __HIP_MEMORY_SCOPE_AGENT)) >= want) break;
                if (__builtin_amdgcn_s_memrealtime() - t0 > 2000000ull) {
                    if (lane == 0) { unsigned expect = 0u; __hip_atomic_compare_exchange_strong(tmo + 1, &expect, code | (unsigned)(u.pm & 0xff), __ATOMIC_RELAXED, __ATOMIC_RELAXED, __HIP_MEMORY_SCOPE_AGENT);
                                     __hip_atomic_store(tmo, 1u, __ATOMIC_RELAXED, __HIP_MEMORY_SCOPE_AGENT); }
                    dead = true; break; }
                __builtin_amdgcn_s_sleep(2);
            }
            __builtin_amdgcn_fence(__ATOMIC_ACQUIRE, "agent");
            if (lane == 0) flag[0] = dead ? 1u : 0u;
        }
        asm volatile("s_waitcnt vmcnt(0) lgkmcnt(0)" ::: "memory"); __builtin_amdgcn_s_barrier(); asm volatile("" ::: "memory");
        const bool bad = flag[0] != 0u;
        if (lane < 32) {
            const unsigned long long* slot = (const unsigned long long*)xbuf + (size_t)(u.pm * BM + row) * 4; float mt[4], m2[4]; float ms = 0.f;
#pragma unroll
            for (int t = 0; t < 4; ++t) { if (t < ntn) { const unsigned long long w = __hip_atomic_load(slot + t, __ATOMIC_RELAXED, __HIP_MEMORY_SCOPE_AGENT); mt[t] = __uint_as_float((unsigned)w); m2[t] = __uint_as_float((unsigned)(w >> 32)); } else { mt[t] = 0.f; m2[t] = 0.f; } ms += mt[t]; }
            const float mean = ms / (float)ntn; float q = 0.f;
#pragma unroll
            for (int t = 0; t < 4; ++t) if (t < ntn) { const float dm = mt[t] - mean; q += m2[t] + 256.0f * dm * dm; }
            S[row] = (f32x2v){mean, 1.0f / sqrtf(q / (256.0f * (float)ntn) + eps)};
        }
        asm volatile("s_waitcnt lgkmcnt(0)" ::: "memory"); __builtin_amdgcn_s_barrier(); asm volatile("" ::: "memory");
        return bad;
    }
};
template <class Epi, class Sched, bool ALIGN_EPI = false, bool SP2 = false>
__device__ __forceinline__ void gemm_phase(PG8_LAS unsigned char* lds, const Gemm g, const Sched& S, const Epi& E) {
    const int tid = threadIdx.x, wid = __builtin_amdgcn_readfirstlane(tid >> 6), lane = tid & 63, wr = wid >> 2, wc = wid & 3, fr = lane & 15, fq = lane >> 4;
    const int K = g.K, nt = K / BK;
    unsigned voffA[2], voffB[2];
#pragma unroll
    for (int i = 0; i < 2; ++i) { int R, C; stage_rc(tid * 16 + i * 8192, R, C); const int Rb = Epi::PERM ? ((R & ~31) + perm32(R & 31)) : R;
        voffA[i] = (unsigned)(R * K + C) * 2u; voffB[i] = (unsigned)(Rb * K + C) * 2u; }
    const size_t kstep = (size_t)(BK * 2);
    const size_t hstep = (size_t)HALF * K * 2;
    const size_t tstep = 2 * hstep;
    const unsigned ldsw = (unsigned)wid * 1024u;
    const int aoff = lds_byte(wr * 64 + fr, fq * 8), boff = lds_byte(wc * 32 + fr, fq * 8);
#define PG8_SA(b, h) (((b) * 2 + (h)) * HTB)
#define PG8_SB(b, h) ((4 + (b) * 2 + (h)) * HTB)
#define PG8_STAGE(bufoff, gbase, voff) do { _Pragma("unroll") for (int _i = 0; _i < 2; ++_i) \
        __builtin_amdgcn_global_load_lds((const unsigned*)((const char*)(gbase) + (voff)[_i]), (PG8_LAS unsigned*)(lds + (bufoff) + ldsw + _i * 8192), 16, 0, 0); } while (0)
#define PG8_LDA(dst, b, h) do { _Pragma("unroll") for (int m = 0; m < 4; ++m) _Pragma("unroll") for (int k = 0; k < 2; ++k) dst[m][k] = *(const PG8_LAS bf16x8*)(lds + PG8_SA(b, h) + aoff + m * 2048 + k * 1024); } while (0)
#define PG8_LDB(dst, b, h) do { _Pragma("unroll") for (int n = 0; n < 2; ++n) _Pragma("unroll") for (int k = 0; k < 2; ++k) dst[n][k] = *(const PG8_LAS bf16x8*)(lds + PG8_SB(b, h) + boff + n * 2048 + k * 1024); } while (0)
#define PG8_MMA(ai, bj, At, Bt) do { __builtin_amdgcn_s_setprio(1); _Pragma("unroll") for (int m = 0; m < 4; ++m) _Pragma("unroll") for (int n = 0; n < 2; ++n) _Pragma("unroll") for (int k = 0; k < 2; ++k) \
        acc[ai][bj][m][n] = __builtin_amdgcn_mfma_f32_16x16x32_bf16(Bt[n][k], At[m][k], acc[ai][bj][m][n], 0, 0, 0); __builtin_amdgcn_s_setprio(0); } while (0)
#define PG8_WAIT_V(n) asm volatile("s_waitcnt vmcnt(" #n ")" ::: "memory")
#define PG8_WAIT_L(n) asm volatile("s_waitcnt lgkmcnt(" #n ")" ::: "memory")
#define PG8_BAR __builtin_amdgcn_s_barrier()
#define PG8_SCHED __builtin_amdgcn_sched_barrier(0)
    Unit cur, nxt; int ui = 0;
    if (!S.next(0, cur)) return;
    f32x4 acc[2][2][4][2];
#pragma unroll
    for (int a = 0; a < 2; ++a)
#pragma unroll
        for (int b = 0; b < 2; ++b)
#pragma unroll
            for (int m = 0; m < 4; ++m)
#pragma unroll
                for (int n = 0; n < 2; ++n) acc[a][b][m][n] = (f32x4){0.f, 0.f, 0.f, 0.f};
    bf16x8 At[4][2], B0[2][2], B1[2][2];
    const char* cA = (const char*)g.A + (size_t)cur.pm * tstep; const char* cB = (const char*)g.Bt + (size_t)cur.pn * tstep;
    S.a_ready(cur);
    if constexpr (SP2) {
        PG8_STAGE(PG8_SB(0, 0), cB, voffB); PG8_STAGE(PG8_SB(0, 1), cB + hstep, voffB); PG8_STAGE(PG8_SA(0, 0), cA, voffA); PG8_STAGE(PG8_SA(0, 1), cA + hstep, voffA);
        if (wr == 1) PG8_BAR;
        PG8_WAIT_V(2); PG8_BAR;
        PG8_STAGE(PG8_SB(1, 0), cB + kstep, voffB); PG8_STAGE(PG8_SA(1, 0), cA + kstep, voffA); PG8_STAGE(PG8_SB(1, 1), cB + hstep + kstep, voffB);
        PG8_WAIT_V(6); PG8_BAR;
    } else {
        PG8_STAGE(PG8_SB(0, 0), cB, voffB); PG8_STAGE(PG8_SA(0, 0), cA, voffA); PG8_STAGE(PG8_SB(0, 1), cB + hstep, voffB); PG8_STAGE(PG8_SA(0, 1), cA + hstep, voffA);
        if (wr == 1) PG8_BAR;
        PG8_WAIT_V(4); PG8_BAR;
        PG8_STAGE(PG8_SB(1, 0), cB + kstep, voffB); PG8_STAGE(PG8_SA(1, 0), cA + kstep, voffA); PG8_STAGE(PG8_SB(1, 1), cB + hstep + kstep, voffB);
        PG8_WAIT_V(6); PG8_BAR;
    }
    for (;;) {
        const bool has_next = S.next(ui + 1, nxt);
        const char* nA = has_next ? (const char*)g.A + (size_t)nxt.pm * tstep : cA; const char* nB = has_next ? (const char*)g.Bt + (size_t)nxt.pn * tstep : cB;
        for (int t = 0; t < nt; t += 2) {
            const bool last = (t == nt - 2);
            const char* a1 = cA + (size_t)(t + 1) * kstep;
            const char* a2 = last ? nA : cA + (size_t)(t + 2) * kstep; const char* b2 = last ? nB : cB + (size_t)(t + 2) * kstep;
            const char* a3 = a2 + kstep; const char* b3 = b2 + kstep;
            if (last && has_next) S.a_ready(nxt);
            if constexpr (SP2) {
            PG8_LDB(B0, 0, 0); PG8_LDB(B1, 0, 1); PG8_SCHED; PG8_LDA(At, 0, 0); PG8_STAGE(PG8_SA(1, 1), a1 + hstep, voffA);
            PG8_WAIT_V(8); PG8_WAIT_L(0); PG8_BAR; PG8_MMA(0, 0, At, B0); PG8_MMA(0, 1, At, B1); PG8_BAR; PG8_SCHED;
            PG8_LDA(At, 0, 1); PG8_STAGE(PG8_SB(0, 0), b2, voffB); PG8_STAGE(PG8_SB(0, 1), b2 + hstep, voffB); PG8_STAGE(PG8_SA(0, 0), a2, voffA);
            PG8_WAIT_V(8); PG8_WAIT_L(0); PG8_BAR; PG8_MMA(1, 0, At, B0); PG8_MMA(1, 1, At, B1); PG8_BAR; PG8_SCHED;
            PG8_LDB(B0, 1, 0); PG8_LDB(B1, 1, 1); PG8_SCHED; PG8_LDA(At, 1, 0); PG8_STAGE(PG8_SA(0, 1), a2 + hstep, voffA);
            PG8_WAIT_V(8); PG8_WAIT_L(0); PG8_BAR; PG8_MMA(0, 0, At, B0); PG8_MMA(0, 1, At, B1); PG8_BAR; PG8_SCHED;
            PG8_LDA(At, 1, 1); PG8_STAGE(PG8_SB(1, 0), b3, voffB); PG8_STAGE(PG8_SB(1, 1), b3 + hstep, voffB); PG8_STAGE(PG8_SA(1, 0), a3, voffA);
            PG8_WAIT_V(8); PG8_WAIT_L(0); PG8_BAR; PG8_MMA(1, 0, At, B0); PG8_MMA(1, 1, At, B1); PG8_BAR; PG8_SCHED;
            } else {
            PG8_LDB(B0, 0, 0); PG8_SCHED; PG8_LDA(At, 0, 0); PG8_STAGE(PG8_SA(1, 1), a1 + hstep, voffA);
            PG8_WAIT_L(8); PG8_BAR; PG8_WAIT_L(0); PG8_MMA(0, 0, At, B0); PG8_BAR; PG8_SCHED;
            PG8_LDB(B1, 0, 1); PG8_STAGE(PG8_SB(0, 0), b2, voffB);
            PG8_BAR; PG8_WAIT_L(0); PG8_MMA(0, 1, At, B1); PG8_BAR;
            PG8_LDA(At, 0, 1); PG8_STAGE(PG8_SA(0, 0), a2, voffA);
            PG8_BAR; PG8_WAIT_L(0); PG8_MMA(1, 0, At, B0); PG8_BAR; PG8_SCHED;
            PG8_STAGE(PG8_SB(0, 1), b2 + hstep, voffB);
            PG8_WAIT_V(6); PG8_BAR; PG8_MMA(1, 1, At, B1); PG8_BAR;
            PG8_LDB(B0, 1, 0); PG8_SCHED; PG8_LDA(At, 1, 0); PG8_STAGE(PG8_SA(0, 1), a2 + hstep, voffA);
            PG8_WAIT_L(8); PG8_BAR; PG8_WAIT_L(0); PG8_MMA(0, 0, At, B0); PG8_BAR; PG8_SCHED;
            PG8_LDB(B1, 1, 1); PG8_STAGE(PG8_SB(1, 0), b3, voffB);
            PG8_BAR; PG8_WAIT_L(0); PG8_MMA(0, 1, At, B1); PG8_BAR;
            PG8_LDA(At, 1, 1); PG8_STAGE(PG8_SA(1, 0), a3, voffA);
            PG8_BAR; PG8_WAIT_L(0); PG8_MMA(1, 0, At, B0); PG8_BAR; PG8_SCHED;
            PG8_STAGE(PG8_SB(1, 1), b3 + hstep, voffB);
            PG8_WAIT_V(6); PG8_BAR; PG8_MMA(1, 1, At, B1); PG8_BAR;
            }
        }
        if constexpr (ALIGN_EPI) { if (wr == 0) PG8_BAR; }
        if constexpr (!Epi::AFTER_DRAIN) { E(acc, cur, wr, wc, fr, fq); S.done(cur); }
        if (!has_next) break;
#pragma unroll
        for (int a = 0; a < 2; ++a)
#pragma unroll
            for (int b = 0; b < 2; ++b)
#pragma unroll
                for (int m = 0; m < 4; ++m)
#pragma unroll
                    for (int n = 0; n < 2; ++n) acc[a][b][m][n] = (f32x4){0.f, 0.f, 0.f, 0.f};
        cur = nxt; cA = nA; cB = nB; ++ui;
        if constexpr (ALIGN_EPI) { if (wr == 1) PG8_BAR; }
    }
    PG8_WAIT_V(0);
    if constexpr (!ALIGN_EPI) { if (wr == 0) PG8_BAR; }
    PG8_BAR;
    if constexpr (Epi::AFTER_DRAIN) { E.fused(acc, cur, wr, wc, fr, fq, lds, wid, lane); S.done(cur); }
#undef PG8_SA
#undef PG8_SB
#undef PG8_STAGE
#undef PG8_LDA
#undef PG8_LDB
#undef PG8_MMA
#undef PG8_WAIT_V
#undef PG8_WAIT_L
#undef PG8_BAR
#undef PG8_SCHED
}
}
constexpr int NWAVES = 8;
constexpr int DM = 1024, SEQ = 2048, NB = 8, DB = 128, DT = 4, WBUF = 2048;
constexpr int MP = NB * SEQ, MS = DB * DT, M = MP + MS;
constexpr int DATT = 512, DSSM = 512, DIN = 2048, DFF = 2816, NMEM = 256, MM = NB * NMEM;
constexpr int NG = 32, NP = 64, NCH = 16, NH = 8, HD = 64;
constexpr float LN_EPS = 1e-5f, ALPHA = 1.189207115002721f;
constexpr float QSCALE = 0.125f * 1.4426950408889634f;
constexpr float MQSCALE = 0.0625f * 1.4426950408889634f;
constexpr size_t O_YP = 0, O_YS = 16777216, O_WKP = 17301504, O_WVP = 25690112, O_WKS = 34078720, O_WVS = 34340864, O_SRP = 34603008, O_SIP = 34619392,
                 O_SRS = 34635776, O_SIS = 34897920, O_MKP = 35160064, O_MVP = 37257216, O_END = 39354368;
enum { I_XP = 0, I_XS, I_CWK, I_CWV, I_SRE, I_SIM, I_CMK, I_CMV, I_MEMP, I_WIN, I_GATT, I_GSSM, I_ARE, I_AIM, I_LDT, I_BRE, I_BIM, I_CRE, I_CIM, I_DSK, I_WGLU, I_BGLU, I_WOUT,
       I_LN1G, I_LN1B, I_WMQ, I_WMK, I_WMV, I_WMO, I_LN2G, I_LN2B, I_WGATE, I_WUP, I_WDOWN, I_LN3G, I_LN3B, N_IN };
constexpr size_t MiB = 1u << 20;
constexpr size_t al(size_t x) { return (x + 4095) & ~(size_t)4095; }
constexpr size_t WS_CTL = 0, CTL_ZERO_BYTES = 1 * MiB;
constexpr size_t WS_WIN = 2 * MiB;
constexpr size_t WS_WGLU = WS_WIN + al((size_t)DIN * DM * 2);
constexpr size_t WS_WOUT = WS_WGLU + al((size_t)DSSM * DSSM * 2);
constexpr size_t WS_WMQ = WS_WOUT + al((size_t)DM * DM * 2);
constexpr size_t WS_WMKV = WS_WMQ + al((size_t)DM * DM * 2);
constexpr size_t WS_WMO = WS_WMKV + al((size_t)2 * DM * DM * 2);
constexpr size_t WS_WGU = WS_WMO + al((size_t)DM * DM * 2);
constexpr size_t WS_WDN = WS_WGU + al((size_t)2 * DFF * DM * 2);
constexpr size_t WS_XB = WS_WDN + al((size_t)DM * DFF * 2);
constexpr size_t WS_MPB = WS_XB + al((size_t)M * DM * 2);
constexpr size_t WS_QB = WS_MPB + al((size_t)MM * DM * 2);
constexpr size_t WS_KB = WS_QB + al((size_t)M * 512 * 2);
constexpr size_t WS_VB = WS_KB + al((size_t)M * 512 * 2);
constexpr size_t WS_UB = WS_VB + al((size_t)M * 512 * 2);
constexpr size_t WS_MKB = WS_UB + al((size_t)M * 512 * 2);
constexpr size_t WS_MVB = WS_MKB + al((size_t)MM * DM * 2);
constexpr size_t WS_ATT = WS_MVB + al((size_t)MM * DM * 2);
constexpr size_t WS_GB = WS_ATT + al((size_t)M * 512 * 2);
constexpr size_t WS_YS = WS_GB + al((size_t)M * 512 * 2);
constexpr size_t WS_A2 = WS_YS + al((size_t)M * 512 * 2);
constexpr size_t WS_PRE = WS_A2 + al((size_t)M * DM * 2);
constexpr size_t WS_X1 = WS_PRE + al((size_t)M * DM * 4);
constexpr size_t WS_X1B = WS_X1 + al((size_t)M * DM * 4);
constexpr size_t WS_X2 = WS_X1B + al((size_t)M * DM * 2);
constexpr size_t WS_X2B = WS_X2 + al((size_t)M * DM * 4);
constexpr size_t WS_QM = WS_X2B + al((size_t)M * DM * 2);
constexpr size_t WS_OM = WS_QM + al((size_t)M * DM * 2);
constexpr size_t WS_H = WS_OM + al((size_t)M * DM * 2);
constexpr size_t WS_HF = WS_H + al((size_t)M * DFF * 2);
constexpr size_t WS_END = WS_HF + al((size_t)2 * M * 2048 * 4);
constexpr int CW_TMO = 0, CW_CODE = 1, CW_BAR = 4096;

constexpr int RING_OFF = 0, RING_BYTES = 131072;
constexpr int LDSCTL_OFF = RING_BYTES, MISC_OFF = LDSCTL_OFF + 320;
constexpr int LDS_BYTES = 147456;

#define GAS __attribute__((address_space(1)))
#define LAS __attribute__((address_space(3)))
typedef unsigned short bf16;
typedef unsigned v4u __attribute__((ext_vector_type(4)));
typedef float f32x4 __attribute__((ext_vector_type(4)));
typedef short bf16x8 __attribute__((ext_vector_type(8)));
typedef GAS unsigned gu32;
typedef GAS unsigned long long gu64;
#define RLX_AGENT __ATOMIC_RELAXED, __HIP_MEMORY_SCOPE_AGENT
#define LDS_WAIT() asm volatile("s_waitcnt lgkmcnt(0)" ::: "memory")
#define VM_WAIT() asm volatile("s_waitcnt vmcnt(0)" ::: "memory")
__device__ __forceinline__ unsigned long long rt() { return __builtin_amdgcn_s_memrealtime(); }
__device__ __forceinline__ unsigned f2bf(float f) { unsigned u = __builtin_bit_cast(unsigned, f); return (u + 0x7fffu + ((u >> 16) & 1u)) >> 16; }
__device__ __forceinline__ unsigned pk2(float lo, float hi) { return f2bf(lo) | (f2bf(hi) << 16); }

#define XB_TMO      128
#define XB_XCNT(j)  (256  + 64 * (j))
#define XB_XSUB(j)  (1280 + 64 * (j))
#define XB_XGEN(j)  (2304 + 64 * (j))
#define XB_TOP      3328
#define XB_TOPGEN   3392
#define XCD_BAR_WORDS 3456
#define XB_SPIN_CAP (1u << 18)

__device__ __forceinline__ unsigned xb_ld(unsigned* p)              { return __hip_atomic_load(p, __ATOMIC_RELAXED, __HIP_MEMORY_SCOPE_AGENT); }
__device__ __forceinline__ unsigned xb_add(unsigned* p, unsigned v) { return __hip_atomic_fetch_add(p, v, __ATOMIC_RELAXED, __HIP_MEMORY_SCOPE_AGENT); }
__device__ __forceinline__ unsigned xb_xcc_id() { return (unsigned)__builtin_amdgcn_s_getreg((3 << 11) | 20) & 0xFu; }
#define XB_SPIN(cond, bar) do { unsigned _sp = 0; while (cond) { __builtin_amdgcn_s_sleep(1); \
    if ((++_sp & 255u) == 0u) { if (xb_ld(&(bar)[XB_TMO])) break; if (_sp > XB_SPIN_CAP) { atomicAdd(&(bar)[XB_TMO], 1u); break; } } } } while (0)

struct XcdBarrier {
    unsigned* bar; unsigned x;
    volatile LAS unsigned* st;
};

__device__ __forceinline__ XcdBarrier xcd_barrier_post(unsigned* bar, volatile LAS unsigned* st) {
    XcdBarrier b; b.bar = bar; b.x = xb_xcc_id(); b.st = st;
    if (threadIdx.x == 0) (void)xb_add(&bar[XB_XCNT(b.x)], 1u);
    return b;
}
__device__ __forceinline__ void xcd_barrier_complete(unsigned* bar, unsigned x, unsigned& nloc, unsigned& nx) {
    const unsigned G = gridDim.x * gridDim.y * gridDim.z;
    unsigned sum, cnt, mine, sp = 0u;
    for (;;) {
        sum = 0u; cnt = 0u; mine = 0u;
#pragma unroll
        for (unsigned j = 0; j < 16; ++j) { const unsigned c = xb_ld(&bar[XB_XCNT(j)]); sum += c; cnt += (c > 0u) ? 1u : 0u; mine = (j == x) ? c : mine; }
        if (sum == G) break;
        __builtin_amdgcn_s_sleep(1);
        if ((++sp & 255u) == 0u) { if (xb_ld(&bar[XB_TMO])) break; if (sp > XB_SPIN_CAP) { atomicAdd(&bar[XB_TMO], 1u); break; } }
    }
    nloc = mine > 0u ? mine : 1u; nx = cnt > 0u ? cnt : 1u;
}

__device__ __forceinline__ void xcd_barrier(const XcdBarrier& b) {
    asm volatile("s_waitcnt vmcnt(0)" ::: "memory");
    __syncthreads();
    if (threadIdx.x == 0) {
        unsigned* bar = b.bar;
        __builtin_amdgcn_s_waitcnt(0);
        unsigned nloc = b.st[0], nx = b.st[1];
        if (nloc == 0u) { xcd_barrier_complete(bar, b.x, nloc, nx); b.st[0] = nloc; b.st[1] = nx; }
        const unsigned old = xb_add(&bar[XB_XSUB(b.x)], 1u);
        const unsigned gen = old / nloc;
        if (old + 1u == (gen + 1u) * nloc) {
            __builtin_amdgcn_fence(__ATOMIC_RELEASE, "agent");
            asm volatile("s_waitcnt vmcnt(0)" ::: "memory");
            const unsigned og = xb_add(&bar[XB_TOP], 1u);
            const unsigned tg = og / nx;
            if (og + 1u == (tg + 1u) * nx) xb_add(&bar[XB_TOPGEN], 1u);
            else XB_SPIN(xb_ld(&bar[XB_TOPGEN]) == tg, bar);
            __builtin_amdgcn_fence(__ATOMIC_ACQUIRE, "agent");
            xb_add(&bar[XB_XGEN(b.x)], 1u);
            asm volatile("s_waitcnt vmcnt(0)" ::: "memory");
        } else {
            XB_SPIN(xb_ld(&bar[XB_XGEN(b.x)]) == gen, bar);
            __builtin_amdgcn_fence(__ATOMIC_ACQUIRE, "agent");
            asm volatile("s_waitcnt vmcnt(0)" ::: "memory");
        }
    }
    __syncthreads();
}
__device__ __forceinline__ float bf2f(bf16 b) { return __uint_as_float((unsigned)b << 16); }
__device__ __forceinline__ float wave_sum(float v) {
#pragma unroll
    for (int o = 1; o < 64; o <<= 1) v += __shfl_xor(v, o);
    return v;
}
struct Args { const float* in[N_IN]; float* out; unsigned char* ws; int ph_lo, ph_hi; };

template <int MODE>
__device__ __forceinline__ void p0_transpose_item(const float* W, int K, int N, bf16* WT, int row_off, LAS float* scr, int item, int lane) {
    const int nblk = N / 32, kb = item / nblk, nb = item % nblk, k0 = 64 * kb, n0 = 32 * nb;
#pragma unroll 8
    for (int i = 0; i < 32; ++i) { const int kk = 2 * i + (lane >> 5); scr[kk * 33 + (lane & 31)] = W[(size_t)(k0 + kk) * N + n0 + (lane & 31)]; }
    LDS_WAIT(); asm volatile("" ::: "memory");
    const int c = lane & 7;
#pragma unroll
    for (int j = 0; j < 4; ++j) { const int n = (lane >> 3) + 8 * j; const LAS float* s = scr + (8 * c) * 33 + n;
        v4u o; o.x = pk2(s[0 * 33], s[1 * 33]); o.y = pk2(s[2 * 33], s[3 * 33]); o.z = pk2(s[4 * 33], s[5 * 33]); o.w = pk2(s[6 * 33], s[7 * 33]);
        const int nn = n0 + n; const int drow = (MODE == 0) ? (row_off + nn) : (8 * (nn >> 2) + (nn & 3) + row_off);
        *(GAS v4u*)(WT + (size_t)drow * K + k0 + 8 * c) = o; }
    LDS_WAIT(); asm volatile("" ::: "memory");
}
__device__ __forceinline__ void p0_convert(const float* src, bf16* dst, size_t n8, size_t gt, size_t ngt) {
    for (size_t i = gt; i < n8; i += ngt) {
        const f32x4 a = ((const GAS f32x4*)src)[2 * i], b = ((const GAS f32x4*)src)[2 * i + 1];
        v4u o; o.x = pk2(a.x, a.y); o.y = pk2(a.z, a.w); o.z = pk2(b.x, b.y); o.w = pk2(b.z, b.w);
        ((GAS v4u*)dst)[i] = o;
    }
}

__device__ __forceinline__ float gelu_tanh(float x) { const float u = 0.7978845608028654f * (x + 0.044715f * x * x * x); return 0.5f * x * (1.0f + tanhf(u)); }

__device__ __forceinline__ void nv_attn_prompt(int w, int lane, const bf16* QB, const bf16* KB, const bf16* VB, bf16* ATT) {
    const int token = w >> 3, h = w & 7, b = token / SEQ, s = token % SEQ;
    const float q = bf2f(QB[(size_t)token * 512 + h * 64 + lane]);
    float m = -1e30f, l = 0.f, o = 0.f;
    for (int c = 0; c < 3; ++c) { const int d = (c == 0) ? 1 : (c == 1 ? 4 : 16);
        for (int mm = 0; mm <= 128; ++mm) { const int pos = s - mm * d; if (pos < 0) break;
            const size_t kt = ((size_t)b * SEQ + pos) * 512 + h * 64 + lane;
            const float sc = wave_sum(q * bf2f(KB[kt]));
            const float mn = fmaxf(m, sc), corr = exp2f(m - mn), p = exp2f(sc - mn);
            l = l * corr + p; o = o * corr + p * bf2f(VB[kt]); m = mn; } }
    ATT[(size_t)token * 512 + h * 64 + lane] = (bf16)f2bf(o / l);
}
__device__ __forceinline__ void nv_attn_sample(int w, int lane, const bf16* QB, const bf16* KB, const bf16* VB, const float* ck, const float* cv, bf16* ATT) {
    const int tok = w >> 3, h = w & 7, b = tok >> 2, t = tok & 3; const size_t row = (size_t)MP + tok;
    const float q = bf2f(QB[row * 512 + h * 64 + lane]);
    float m = -1e30f, l = 0.f, o = 0.f;
    for (int c = 0; c < 3; ++c) { const int d = (c == 0) ? 1 : (c == 1 ? 4 : 16);
        for (int mm = 0; mm <= 128; ++mm) { const int idx = WBUF + t - mm * d; if (idx < 0) break;
            float kv, vv;
            if (idx >= WBUF) { const size_t kr = ((size_t)MP + b * 4 + (idx - WBUF)) * 512 + h * 64 + lane; kv = bf2f(KB[kr]); vv = bf2f(VB[kr]); }
            else { const size_t kr = (((size_t)b * WBUF + idx) * NH + h) * 64 + lane; kv = ck[kr]; vv = cv[kr]; }
            const float sc = wave_sum(q * kv);
            const float mn = fmaxf(m, sc), corr = exp2f(m - mn), p = exp2f(sc - mn);
            l = l * corr + p; o = o * corr + p * vv; m = mn; } }
    ATT[row * 512 + h * 64 + lane] = (bf16)f2bf(o / l);
}
__device__ __forceinline__ void nv_ssm_scan(int gt, const bf16* UB, const float* are, const float* aim, const float* ldt, const float* bre, const float* bim,
                                                    const float* s0r, const float* s0i, float* HF, float* out) {
    const int p = gt & 63, g = (gt >> 6) & 31, sq = gt >> 11;
    const double dt = exp((double)ldt[g]), ar = are[g * NP + p], ai = aim[g * NP + p];
    const double mag = exp(dt * ar), abr_d = mag * cos(dt * ai), abi_d = mag * sin(dt * ai);
    const double den = ar * ar + ai * ai, nr = abr_d - 1.0, ni = abi_d;
    const double cr = (nr * ar + ni * ai) / den, ci = (ni * ar - nr * ai) / den;
    const float abr = (float)abr_d, abi = (float)abi_d;
    float bbr[NCH], bbi[NCH];
#pragma unroll
    for (int c = 0; c < NCH; ++c) { const double br = bre[(g * NP + p) * NCH + c], bi = bim[(g * NP + p) * NCH + c]; bbr[c] = (float)(cr * br - ci * bi); bbi[c] = (float)(cr * bi + ci * br); }
    float hr = 0.f, hi = 0.f; int L, row0;
    if (sq < NB) { L = SEQ; row0 = sq * SEQ; } else { const int b = sq - NB; L = DT; row0 = MP + b * DT; hr = s0r[(b * NG + g) * NP + p]; hi = s0i[(b * NG + g) * NP + p]; }
    float* HR = HF; float* HI = HF + (size_t)M * 2048;
    for (int t = 0; t < L; ++t) {
        const bf16* up = UB + (size_t)(row0 + t) * 512 + g * NCH;
        float sr = 0.f, si = 0.f;
#pragma unroll
        for (int c = 0; c < NCH; ++c) { const float uv = bf2f(up[c]); sr += bbr[c] * uv; si += bbi[c] * uv; }
        const float nhr = abr * hr - abi * hi + sr, nhi = abr * hi + abi * hr + si; hr = nhr; hi = nhi;
        HR[((size_t)(row0 + t) * NG + g) * NP + p] = hr; HI[((size_t)(row0 + t) * NG + g) * NP + p] = hi;
    }
    if (sq < NB) { out[O_SRP + (sq * NG + g) * NP + p] = hr; out[O_SIP + (sq * NG + g) * NP + p] = hi; }
    else { const int b = sq - NB; out[O_SRS + (b * NG + g) * NP + p] = hr; out[O_SIS + (b * NG + g) * NP + p] = hi; }
}
__device__ __forceinline__ void nv_ssm_out(size_t gt, const bf16* UB, const float* HF, const float* cre, const float* cim, const float* dsk, bf16* GB) {
    const int c = (int)(gt & 511), g = c >> 4, ch = c & 15; const size_t row = gt >> 9;
    const float* HR = HF + (row * NG + g) * NP; const float* HI = HR + (size_t)M * 2048;
    const float* cr = cre + (g * NCH + ch) * NP; const float* ci = cim + (g * NCH + ch) * NP;
    float y = 0.f;
    for (int p = 0; p < NP; ++p) y += cr[p] * HR[p] - ci[p] * HI[p];
    y += dsk[g * NCH + ch] * bf2f(UB[row * 512 + c]);
    GB[row * 512 + c] = (bf16)f2bf(gelu_tanh(y));
}
__device__ __forceinline__ void nv_mixprep(int w, int lane, const bf16* ATT, const bf16* YS, const float* gatt, const float* gssm, bf16* A2) {
    float a[8], y[8]; float sa = 0.f, sy = 0.f;
#pragma unroll
    for (int j = 0; j < 8; ++j) { a[j] = bf2f(ATT[(size_t)w * 512 + j * 64 + lane]); y[j] = bf2f(YS[(size_t)w * 512 + j * 64 + lane]); sa += a[j] * a[j]; sy += y[j] * y[j]; }
    const float ra = rsqrtf(wave_sum(sa) * (1.f / 512.f) + LN_EPS), ry = rsqrtf(wave_sum(sy) * (1.f / 512.f) + LN_EPS);
#pragma unroll
    for (int j = 0; j < 8; ++j) { A2[(size_t)w * 1024 + j * 64 + lane] = (bf16)f2bf(a[j] * ra * gatt[j * 64 + lane]); A2[(size_t)w * 1024 + 512 + j * 64 + lane] = (bf16)f2bf(y[j] * ry * gssm[j * 64 + lane]); }
}
__device__ __forceinline__ void nv_ln(int w, int lane, const float* PRE, const float* g, const float* b, float* oP, float* oS, bf16* ob) {
    float v[16]; float s = 0.f;
#pragma unroll
    for (int j = 0; j < 16; ++j) { v[j] = PRE[(size_t)w * 1024 + j * 64 + lane]; s += v[j]; }
    const float mean = wave_sum(s) * (1.f / 1024.f); float q = 0.f;
#pragma unroll
    for (int j = 0; j < 16; ++j) { v[j] -= mean; q += v[j] * v[j]; }
    const float rstd = rsqrtf(wave_sum(q) * (1.f / 1024.f) + LN_EPS);
    float* o = (w < MP) ? oP + (size_t)w * 1024 : oS + (size_t)(w - MP) * 1024;
#pragma unroll
    for (int j = 0; j < 16; ++j) { const float r = v[j] * rstd * g[j * 64 + lane] + b[j * 64 + lane]; o[j * 64 + lane] = r; if (ob) ob[(size_t)w * 1024 + j * 64 + lane] = (bf16)f2bf(r); }
}
__device__ __forceinline__ void nv_memattn(int w, int lane, const bf16* QM, const bf16* MKB, const bf16* MVB, const float* cmk, const float* cmv, bf16* OM) {
    const int row = w >> 2, h = w & 3;
    float q[4], o[4] = {0.f, 0.f, 0.f, 0.f};
#pragma unroll
    for (int j = 0; j < 4; ++j) q[j] = bf2f(QM[(size_t)row * 1024 + h * 256 + j * 64 + lane]);
    float m = -1e30f, l = 0.f;
    for (int mm = 0; mm < NMEM; ++mm) {
        float k[4], v[4];
        if (row < MP) { const size_t kr = ((size_t)(row / SEQ) * NMEM + mm) * 1024 + h * 256 + lane;
#pragma unroll
            for (int j = 0; j < 4; ++j) { k[j] = bf2f(MKB[kr + j * 64]); v[j] = bf2f(MVB[kr + j * 64]); } }
        else { const size_t kr = ((size_t)((row - MP) >> 2) * NMEM + mm) * 1024 + h * 256 + lane;
#pragma unroll
            for (int j = 0; j < 4; ++j) { k[j] = cmk[kr + j * 64]; v[j] = cmv[kr + j * 64]; } }
        const float sc = wave_sum(q[0] * k[0] + q[1] * k[1] + q[2] * k[2] + q[3] * k[3]);
        const float mn = fmaxf(m, sc), corr = exp2f(m - mn), p = exp2f(sc - mn);
        l = l * corr + p; m = mn;
#pragma unroll
        for (int j = 0; j < 4; ++j) o[j] = o[j] * corr + p * v[j];
    }
#pragma unroll
    for (int j = 0; j < 4; ++j) OM[(size_t)row * 1024 + h * 256 + j * 64 + lane] = (bf16)f2bf(o[j] / l);
}

__global__ void __launch_bounds__(NWAVES * 64, 2) skel_fwd(Args args) {
    extern __shared__ __attribute__((aligned(16))) unsigned char lds[];
    LAS unsigned char* L = (LAS unsigned char*)lds;
    volatile LAS unsigned* MISC = (volatile LAS unsigned*)(L + MISC_OFF);
    const int tid = threadIdx.x, lane = tid & 63, wave = __builtin_amdgcn_readfirstlane(tid >> 6);
    const int G = gridDim.x; const int bx = blockIdx.x; const int vcu = (G % 8 == 0) ? (bx % 8) * (G / 8) + bx / 8 : bx;
    unsigned char* ws = args.ws;
    gu32* ctl = (gu32*)(ws + WS_CTL);
    for (int u = tid; u < (LDS_BYTES - LDSCTL_OFF) / 4; u += NWAVES * 64) ((LAS unsigned*)(L + LDSCTL_OFF))[u] = 0u;
    __syncthreads();
    XcdBarrier bar = xcd_barrier_post((unsigned*)(ctl + CW_BAR), MISC + 8);
#define GRID_BAR() xcd_barrier(bar)
    const int lo = args.ph_lo, hi = args.ph_hi;
#define IN(k) (lo <= (k) && (k) < hi)
#define BOTH(k) (IN(k) && IN((k) + 1))
    bf16* WIN_t = (bf16*)(ws + WS_WIN); bf16* WGLU_t = (bf16*)(ws + WS_WGLU); bf16* WOUT_t = (bf16*)(ws + WS_WOUT); bf16* WMQ_t = (bf16*)(ws + WS_WMQ);
    bf16* WMKV_t = (bf16*)(ws + WS_WMKV); bf16* WMO_t = (bf16*)(ws + WS_WMO); bf16* WGU_t = (bf16*)(ws + WS_WGU); bf16* WDN_t = (bf16*)(ws + WS_WDN);
    bf16* XB = (bf16*)(ws + WS_XB); bf16* MPB = (bf16*)(ws + WS_MPB);
    bf16* QB = (bf16*)(ws + WS_QB); bf16* KB = (bf16*)(ws + WS_KB); bf16* VB = (bf16*)(ws + WS_VB); bf16* UB = (bf16*)(ws + WS_UB);
    bf16* MKB = (bf16*)(ws + WS_MKB); bf16* MVB = (bf16*)(ws + WS_MVB);
    bf16* GB = (bf16*)(ws + WS_GB); bf16* YS = (bf16*)(ws + WS_YS); bf16* A2 = (bf16*)(ws + WS_A2);
    float* PRE = (float*)(ws + WS_PRE); float* X1 = (float*)(ws + WS_X1); bf16* X1B = (bf16*)(ws + WS_X1B); float* X2 = (float*)(ws + WS_X2); bf16* X2B = (bf16*)(ws + WS_X2B);
    bf16* QM = (bf16*)(ws + WS_QM); bf16* OM = (bf16*)(ws + WS_OM); bf16* HB = (bf16*)(ws + WS_H);
    float* out = args.out;

    if (IN(0)) {
        LAS float* scr = (LAS float*)(L + RING_OFF + wave * 16384);
        const int gw = vcu * NWAVES + wave, NGW = G * NWAVES;
        constexpr int I_IN = (DM / 64) * (DIN / 32), I_GLU = (DSSM / 64) * (DSSM / 32), I_SQ = (DM / 64) * (DM / 32), I_FF = (DM / 64) * (DFF / 32), I_DN = (DFF / 64) * (DM / 32);
        constexpr int NITEMS = I_IN + I_GLU + 5 * I_SQ + 2 * I_FF + I_DN;
        for (int it = gw; it < NITEMS; it += NGW) {
            int r = it;
            if (r < I_IN) { p0_transpose_item<0>(args.in[I_WIN], DM, DIN, WIN_t, 0, scr, r, lane); continue; } r -= I_IN;
            if (r < I_GLU) { p0_transpose_item<0>(args.in[I_WGLU], DSSM, DSSM, WGLU_t, 0, scr, r, lane); continue; } r -= I_GLU;
            if (r < I_SQ) { p0_transpose_item<0>(args.in[I_WOUT], DM, DM, WOUT_t, 0, scr, r, lane); continue; } r -= I_SQ;
            if (r < I_SQ) { p0_transpose_item<0>(args.in[I_WMQ], DM, DM, WMQ_t, 0, scr, r, lane); continue; } r -= I_SQ;
            if (r < I_SQ) { p0_transpose_item<0>(args.in[I_WMK], DM, DM, WMKV_t, 0, scr, r, lane); continue; } r -= I_SQ;
            if (r < I_SQ) { p0_transpose_item<0>(args.in[I_WMV], DM, DM, WMKV_t, DM, scr, r, lane); continue; } r -= I_SQ;
            if (r < I_SQ) { p0_transpose_item<0>(args.in[I_WMO], DM, DM, WMO_t, 0, scr, r, lane); continue; } r -= I_SQ;
            if (r < I_FF) { p0_transpose_item<1>(args.in[I_WGATE], DM, DFF, WGU_t, 0, scr, r, lane); continue; } r -= I_FF;
            if (r < I_FF) { p0_transpose_item<1>(args.in[I_WUP], DM, DFF, WGU_t, 4, scr, r, lane); continue; } r -= I_FF;
            p0_transpose_item<0>(args.in[I_WDOWN], DFF, DM, WDN_t, 0, scr, r, lane);
        }
        const size_t gt = (size_t)vcu * (NWAVES * 64) + tid, ngt = (size_t)G * NWAVES * 64;
        p0_convert(args.in[I_XP], XB, (size_t)MP * DM / 8, gt, ngt);
        p0_convert(args.in[I_XS], XB + (size_t)MP * DM, (size_t)MS * DM / 8, gt, ngt);
        p0_convert(args.in[I_MEMP], MPB, (size_t)MM * DM / 8, gt, ngt);
        if (BOTH(0)) GRID_BAR();
    }
    if (IN(1)) {
        { pg8::Gemm g{XB, WIN_t, M, DIN, DM}; pg8::StaticOrder S; S.init(M, DIN, G, bx);
          pg8::EpiIn E{QB, KB, VB, UB, out + O_WKP, out + O_WVP, out + O_WKS, out + O_WVS, QSCALE, MP};
          pg8::gemm_phase<pg8::EpiIn, pg8::StaticOrder, true, true>(L + RING_OFF, g, S, E); }
        { pg8::Gemm g{MPB, WMKV_t, MM, 2 * DM, DM}; pg8::StaticOrder S; S.init(MM, 2 * DM, G, bx);
          pg8::EpiMkv E{out + O_MKP, out + O_MVP, MKB, MVB};
          pg8::gemm_phase<pg8::EpiMkv, pg8::StaticOrder, true, true>(L + RING_OFF, g, S, E); }
        if (BOTH(1)) GRID_BAR();
    }
    const int gw = vcu * NWAVES + wave, NGW = G * NWAVES;
    bf16* ATT = (bf16*)(ws + WS_ATT); float* HF = (float*)(ws + WS_HF);
    if (IN(2)) {
        for (int w = gw; w < MP * NH; w += NGW) nv_attn_prompt(w, lane, QB, KB, VB, ATT);
        for (int w = gw; w < MS * NH; w += NGW) nv_attn_sample(w, lane, QB, KB, VB, args.in[I_CWK], args.in[I_CWV], ATT);
        for (int w = gw; w < (NB + DB) * NG; w += NGW) nv_ssm_scan(w * 64 + lane, UB, args.in[I_ARE], args.in[I_AIM], args.in[I_LDT], args.in[I_BRE], args.in[I_BIM], args.in[I_SRE], args.in[I_SIM], HF, out);
        if (BOTH(2)) GRID_BAR();
    }
    if (IN(3)) {
        for (size_t w = gw; w < (size_t)M * 8; w += NGW) nv_ssm_out(w * 64 + lane, UB, HF, args.in[I_CRE], args.in[I_CIM], args.in[I_DSK], GB);
        if (BOTH(3)) GRID_BAR();
    }
    if (IN(4)) {
        pg8::Gemm g{GB, WGLU_t, M, DSSM, DSSM}; pg8::StaticOrder S; S.init(M, DSSM, G, bx);
        pg8::EpiGlu E{GB, args.in[I_BGLU], YS};
        pg8::gemm_phase<pg8::EpiGlu, pg8::StaticOrder, true, true>(L + RING_OFF, g, S, E);
        if (BOTH(4)) GRID_BAR();
    }
    if (IN(5)) {
        for (int w = gw; w < M; w += NGW) nv_mixprep(w, lane, ATT, YS, args.in[I_GATT], args.in[I_GSSM], A2);
        if (BOTH(5)) GRID_BAR();
    }
    if (IN(6)) {
        pg8::Gemm g{A2, WOUT_t, M, DM, DM}; pg8::StaticOrder S; S.init(M, DM, G, bx);
        pg8::EpiRes E{args.in[I_XP], args.in[I_XS], PRE, ALPHA, MP};
        pg8::gemm_phase<pg8::EpiRes, pg8::StaticOrder, true, true>(L + RING_OFF, g, S, E);
        if (BOTH(6)) GRID_BAR();
    }
    if (IN(7)) {
        for (int w = gw; w < M; w += NGW) nv_ln(w, lane, PRE, args.in[I_LN1G], args.in[I_LN1B], X1, X1 + (size_t)MP * DM, X1B);
        if (BOTH(7)) GRID_BAR();
    }
    if (IN(8)) {
        pg8::Gemm g{X1B, WMQ_t, M, DM, DM}; pg8::StaticOrder S; S.init(M, DM, G, bx);
        pg8::EpiBfS E{QM, DM, MQSCALE};
        pg8::gemm_phase<pg8::EpiBfS, pg8::StaticOrder, true, true>(L + RING_OFF, g, S, E);
        if (BOTH(8)) GRID_BAR();
    }
    if (IN(9)) {
        for (int w = gw; w < M * 4; w += NGW) nv_memattn(w, lane, QM, MKB, MVB, args.in[I_CMK], args.in[I_CMV], OM);
        if (BOTH(9)) GRID_BAR();
    }
    if (IN(10)) {
        pg8::Gemm g{OM, WMO_t, M, DM, DM}; pg8::StaticOrder S; S.init(M, DM, G, bx);
        pg8::EpiRes E{X1, X1 + (size_t)MP * DM, PRE, ALPHA, MP};
        pg8::gemm_phase<pg8::EpiRes, pg8::StaticOrder, true, true>(L + RING_OFF, g, S, E);
        if (BOTH(10)) GRID_BAR();
    }
    if (IN(11)) {
        for (int w = gw; w < M; w += NGW) nv_ln(w, lane, PRE, args.in[I_LN2G], args.in[I_LN2B], X2, X2 + (size_t)MP * DM, X2B);
        if (BOTH(11)) GRID_BAR();
    }
    if (IN(12)) {
        pg8::Gemm g{X2B, WGU_t, M, 2 * DFF, DM}; pg8::StaticOrder S; S.init(M, 2 * DFF, G, bx);
        pg8::EpiGateUp E{HB, DFF};
        pg8::gemm_phase<pg8::EpiGateUp, pg8::StaticOrder, true, true>(L + RING_OFF, g, S, E);
        if (BOTH(12)) GRID_BAR();
    }
    if (IN(13)) {
        pg8::Gemm g{HB, WDN_t, M, DM, DFF}; pg8::StaticOrder S; S.init(M, DM, G, bx);
        pg8::EpiRes E{X2, X2 + (size_t)MP * DM, PRE, ALPHA, MP};
        pg8::gemm_phase<pg8::EpiRes, pg8::StaticOrder, true, true>(L + RING_OFF, g, S, E);
        if (BOTH(13)) GRID_BAR();
    }
    if (IN(14)) {
        for (int w = gw; w < M; w += NGW) nv_ln(w, lane, PRE, args.in[I_LN3G], args.in[I_LN3B], out + O_YP, out + O_YS, nullptr);
    }
#undef IN
#undef BOTH
}

extern "C" void kernel_launch(void* const* d_in, const int* in_sizes, int n_in, void* d_out, int out_size, void* d_ws, size_t ws_size, hipStream_t stream) {
    static int grid = 0;
    if (grid == 0) {
        if (n_in != N_IN || in_sizes[0] != MP * DM || out_size != (int)O_END || ws_size < WS_END) {
            fprintf(stderr, "kernel_launch: shape mismatch: n_in %d in0 %d out %d ws %zu (need %zu); nothing launched\n", n_in, n_in > 0 ? in_sizes[0] : -1, out_size, ws_size, (size_t)WS_END); grid = -1; return; }
        int dev = 0, cus = 0, per_cu = 0;
        if (hipGetDevice(&dev) != hipSuccess || hipDeviceGetAttribute(&cus, hipDeviceAttributeMultiprocessorCount, dev) != hipSuccess) { grid = -1; return; }
        if (hipFuncSetAttribute((const void*)skel_fwd, hipFuncAttributeMaxDynamicSharedMemorySize, LDS_BYTES) != hipSuccess) { fprintf(stderr, "kernel_launch: hipFuncSetAttribute failed\n"); grid = -1; return; }
        if (hipOccupancyMaxActiveBlocksPerMultiprocessor(&per_cu, (const void*)skel_fwd, NWAVES * 64, LDS_BYTES) != hipSuccess || per_cu < 1)
            fprintf(stderr, "kernel_launch: note: occupancy query reports %d workgroups per CU\n", per_cu);
        (void)hipGetLastError();
        grid = cus;
    }
    if (grid < 0) return;
    (void)hipMemsetAsync((char*)d_ws + WS_CTL, 0, CTL_ZERO_BYTES, stream);
    Args a{};
    for (int i = 0; i < N_IN; ++i) a.in[i] = (const float*)d_in[i];
    a.out = (float*)d_out; a.ws = (unsigned char*)d_ws;
    a.ph_lo = 0; a.ph_hi = 15;
    hipLaunchKernelGGL(skel_fwd, dim3(grid), dim3(NWAVES * 64), LDS_BYTES, stream, a);
}
```

```cpp
#include <hip/hip_runtime.h>
#include <cstdio>
#include <cstdint>
namespace pg8 {
#define PG8_LAS __attribute__((address_space(3)))
typedef unsigned short bf16_t;
typedef short bf16x8 __attribute__((ext_vector_type(8)));
typedef float f32x4 __attribute__((ext_vector_type(4)));
typedef unsigned u32x4 __attribute__((ext_vector_type(4)));
constexpr int BM = 256, BK = 64, HALF = 128, HTB = HALF * BK * 2  , STAGE_BYTES = 8 * HTB, NXCD = 8, WGM = 8;

__host__ __device__ __forceinline__ int lds_byte(int r, int c) { const int st = (r >> 4) * 2 + (c >> 5), rr = r & 15, cc = c & 31, ob = rr * 64 + cc * 2; return st * 1024 + (ob ^ (((ob >> 9) & 1) << 5)); }
__host__ __device__ __forceinline__ void stage_rc(int b, int& R, int& C) { const int st = b / 1024, sb = b % 1024, swz = sb ^ (((sb >> 9) & 1) << 5); R = (st >> 1) * 16 + swz / 64; C = (st & 1) * 32 + (swz % 64) / 2; }
__host__ __device__ __forceinline__ int perm32(int rho) { const int n = rho >> 4, i = rho & 15; return 8 * (i >> 2) + 4 * n + (i & 3); }

struct Unit { int pm, pn; };
struct Gemm { const bf16_t* A; const bf16_t* Bt; int M, N, K; int lda = 0, ldb = 0; };

struct StaticOrder {
    int nM, nN, nwg, G, c;
    __host__ __device__ void init(int M, int N, int G_, int c_) { nM = M / BM; nN = N / BM; nwg = nM * nN; G = G_; c = c_; }
    __host__ __device__ bool next(int i, Unit& u) const {
        const long L = (long)i * G + c; if (L >= nwg) return false;
        int wgid = (int)L; { const int q = nwg / NXCD, r = nwg % NXCD, xcd = wgid % NXCD, off = wgid / NXCD; wgid = (xcd < r ? xcd * (q + 1) : r * (q + 1) + (xcd - r) * q) + off; }
        const int nig = WGM * nN, gid = wgid / nig, fm = gid * WGM, gsz = (nM - fm) < WGM ? (nM - fm) : WGM;
        u.pm = fm + ((wgid % nig) % gsz); u.pn = (wgid % nig) / gsz; return true;
    }
    __device__ __forceinline__ void a_ready(const Unit&) const {}
    __device__ __forceinline__ void done(const Unit&) const {}
    __device__ __forceinline__ size_t a_off(const Unit& u, int lda) const { return (size_t)u.pm * BM * lda * 2; }
    __device__ __forceinline__ size_t b_off(const Unit& u, int ldb) const { return (size_t)u.pn * BM * ldb * 2; }
};
template <int BMODE> struct MemOrder {
    int G, c;
    __device__ __forceinline__ bool next(int i, Unit& u) const { const int L = i * G + c; if (L >= 256) return false; u.pm = L >> 2; u.pn = L & 3; return true; }
    __device__ __forceinline__ void a_ready(const Unit&) const {}
    __device__ __forceinline__ void done(const Unit&) const {}
    __device__ __forceinline__ size_t a_off(const Unit& u, int lda) const { return ((size_t)u.pm * BM * lda + (size_t)u.pn * BM) * 2; }
    __device__ __forceinline__ size_t b_off(const Unit& u, int ldb) const { return BMODE == 0 ? ((size_t)(u.pm >> 3) * BM * ldb + (size_t)u.pn * BM) * 2 : ((size_t)u.pn * BM * ldb + (size_t)(u.pm >> 3) * BM) * 2; }
};

__device__ __forceinline__ unsigned cvt_pk_bf16(float lo, float hi) { unsigned r; asm volatile("v_cvt_pk_bf16_f32 %0, %1, %2" : "=v"(r) : "v"(lo), "v"(hi)); return r; }
typedef float f32x2 __attribute__((ext_vector_type(2)));
__device__ __forceinline__ f32x2 gelu_pk(f32x2 v) {
    const f32x2 av = __builtin_elementwise_abs(v), d = av * 0.2316418882f + 1.0f;
    f32x2 t; t.x = __builtin_amdgcn_rcpf(d.x); t.y = __builtin_amdgcn_rcpf(d.y);
    f32x2 q = t * 0.5307027145f + (-0.7265760135f); q = q * t + 0.7107068705f; q = q * t + (-0.142248368f); q = q * t + 0.127414796f; q = q * t;
    const f32x2 s = (v * v) * (-0.72134752044f);
    f32x2 e; e.x = __builtin_amdgcn_exp2f(s.x); e.y = __builtin_amdgcn_exp2f(s.y);
    const f32x2 m = v * (q * e), r = v - m;
    f32x2 o; o.x = v.x < 0.f ? m.x : r.x; o.y = v.y < 0.f ? m.y : r.y; return o;
}

typedef unsigned u32x2 __attribute__((ext_vector_type(2)));
__device__ __forceinline__ float bf_lo(unsigned w) { return __uint_as_float(w << 16); }
__device__ __forceinline__ float bf_hi(unsigned w) { return __uint_as_float(w & 0xffff0000u); }
__device__ __forceinline__ float sigmoidf_(float x) { return __builtin_amdgcn_rcpf(1.0f + __builtin_amdgcn_exp2f(-1.4426950408889634f * x)); }

struct EpiIn {
    static constexpr bool PERM = true, AFTER_DRAIN = false;
    bf16_t *Q, *Kb, *Vb, *U; float *wkp, *wvp, *wks, *wvs; float qscale; int mp;
    __device__ __forceinline__ void operator()(const f32x4 (&acc)[2][2][4][2], const Unit& u, int wr, int wc, int fr, int fq) const {
        const int t = u.pn >> 1, colt = (u.pn & 1) * BM;
        bf16_t* base = t == 0 ? Q : (t == 1 ? Kb : (t == 2 ? Vb : U));
        const float sc = t == 0 ? qscale : 1.f;
        const bool prompt = u.pm * BM < mp;
        float* fo = (t == 1) ? (prompt ? wkp : wks) : ((t == 2) ? (prompt ? wvp : wvs) : nullptr);
        const int row0 = u.pm * BM + wr * 64 + fr, frow0 = prompt ? row0 : row0 - mp, col0 = colt + wc * 32 + 8 * fq;
#pragma unroll
        for (int ai = 0; ai < 2; ++ai)
#pragma unroll
            for (int m = 0; m < 4; ++m) {
                const size_t ro = (size_t)(row0 + ai * HALF + m * 16) * 512 + col0, fro = (size_t)(frow0 + ai * HALF + m * 16) * 512 + col0;
#pragma unroll
                for (int bj = 0; bj < 2; ++bj) {
                    const f32x4 v0 = acc[ai][bj][m][0] * sc, v1 = acc[ai][bj][m][1] * sc;
                    u32x4 w; w.x = cvt_pk_bf16(v0[0], v0[1]); w.y = cvt_pk_bf16(v0[2], v0[3]); w.z = cvt_pk_bf16(v1[0], v1[1]); w.w = cvt_pk_bf16(v1[2], v1[3]);
                    *(u32x4*)(base + ro + bj * HALF) = w;
                    if (fo) { *(f32x4*)(fo + fro + bj * HALF) = v0; *(f32x4*)(fo + fro + bj * HALF + 4) = v1; }
                }
            }
    }
};
struct EpiMkv {
    static constexpr bool PERM = false, AFTER_DRAIN = false;
    float *ko, *vo; bf16_t *kb, *vb;
    __device__ __forceinline__ void operator()(const f32x4 (&acc)[2][2][4][2], const Unit& u, int wr, int wc, int fr, int fq) const {
        const int t = u.pn >> 2, colt = (u.pn & 3) * BM;
        float* fo = t ? vo : ko; bf16_t* bo = t ? vb : kb;
        const int row0 = u.pm * BM + wr * 64 + fr, col0 = colt + wc * 32 + 4 * fq;
#pragma unroll
        for (int ai = 0; ai < 2; ++ai)
#pragma unroll
            for (int m = 0; m < 4; ++m) { const size_t ro = (size_t)(row0 + ai * HALF + m * 16) * 1024 + col0;
#pragma unroll
                for (int bj = 0; bj < 2; ++bj)
#pragma unroll
                    for (int n = 0; n < 2; ++n) { const f32x4 v = acc[ai][bj][m][n]; *(f32x4*)(fo + ro + bj * HALF + n * 16) = v;
                        u32x2 w; w.x = cvt_pk_bf16(v[0], v[1]); w.y = cvt_pk_bf16(v[2], v[3]); *(u32x2*)(bo + ro + bj * HALF + n * 16) = w; } }
    }
};
struct EpiRes {
    static constexpr bool PERM = false, AFTER_DRAIN = false;
    const float *resP, *resS; float* out; float alpha; int mp;
    __device__ __forceinline__ void operator()(const f32x4 (&acc)[2][2][4][2], const Unit& u, int wr, int wc, int fr, int fq) const {
        const bool prompt = u.pm * BM < mp;
        const float* rs = prompt ? resP : resS;
        const int row0 = u.pm * BM + wr * 64 + fr, rrow0 = prompt ? row0 : row0 - mp, col0 = u.pn * BM + wc * 32 + 4 * fq;
#pragma unroll
        for (int ai = 0; ai < 2; ++ai)
#pragma unroll
            for (int m = 0; m < 4; ++m) { const size_t ro = (size_t)(row0 + ai * HALF + m * 16) * 1024 + col0, rro = (size_t)(rrow0 + ai * HALF + m * 16) * 1024 + col0;
#pragma unroll
                for (int bj = 0; bj < 2; ++bj)
#pragma unroll
                    for (int n = 0; n < 2; ++n) { const f32x4 r = *(const f32x4*)(rs + rro + bj * HALF + n * 16); *(f32x4*)(out + ro + bj * HALF + n * 16) = r * alpha + acc[ai][bj][m][n]; } }
    }
};
struct EpiBfS {
    static constexpr bool PERM = true, AFTER_DRAIN = false;
    bf16_t* O; int ldc; float scale;
    __device__ __forceinline__ void operator()(const f32x4 (&acc)[2][2][4][2], const Unit& u, int wr, int wc, int fr, int fq) const {
        const int row0 = u.pm * BM + wr * 64 + fr, col0 = u.pn * BM + wc * 32 + 8 * fq;
#pragma unroll
        for (int ai = 0; ai < 2; ++ai)
#pragma unroll
            for (int m = 0; m < 4; ++m) { bf16_t* rowp = O + (size_t)(row0 + ai * HALF + m * 16) * ldc + col0;
#pragma unroll
                for (int bj = 0; bj < 2; ++bj) { const f32x4 v0 = acc[ai][bj][m][0] * scale, v1 = acc[ai][bj][m][1] * scale;
                    u32x4 w; w.x = cvt_pk_bf16(v0[0], v0[1]); w.y = cvt_pk_bf16(v0[2], v0[3]); w.z = cvt_pk_bf16(v1[0], v1[1]); w.w = cvt_pk_bf16(v1[2], v1[3]);
                    *(u32x4*)(rowp + bj * HALF) = w; } }
    }
};
struct EpiGlu {
    static constexpr bool PERM = true, AFTER_DRAIN = false;
    const bf16_t* Gb; const float* bias; bf16_t* O;
    __device__ __forceinline__ void operator()(const f32x4 (&acc)[2][2][4][2], const Unit& u, int wr, int wc, int fr, int fq) const {
        const int row0 = u.pm * BM + wr * 64 + fr, col0 = u.pn * BM + wc * 32 + 8 * fq;
        f32x4 bv[2][2];
#pragma unroll
        for (int bj = 0; bj < 2; ++bj)
#pragma unroll
            for (int n = 0; n < 2; ++n) bv[bj][n] = *(const f32x4*)(bias + col0 + bj * HALF + 4 * n);
#pragma unroll
        for (int ai = 0; ai < 2; ++ai)
#pragma unroll
            for (int m = 0; m < 4; ++m) { const size_t ro = (size_t)(row0 + ai * HALF + m * 16) * 512 + col0;
#pragma unroll
                for (int bj = 0; bj < 2; ++bj) {
                    const u32x4 gw = *(const u32x4*)(Gb + ro + bj * HALF);
                    const f32x4 z0 = acc[ai][bj][m][0] + bv[bj][0], z1 = acc[ai][bj][m][1] + bv[bj][1];
                    float o[8];
                    o[0] = bf_lo(gw.x) * sigmoidf_(z0[0]); o[1] = bf_hi(gw.x) * sigmoidf_(z0[1]); o[2] = bf_lo(gw.y) * sigmoidf_(z0[2]); o[3] = bf_hi(gw.y) * sigmoidf_(z0[3]);
                    o[4] = bf_lo(gw.z) * sigmoidf_(z1[0]); o[5] = bf_hi(gw.z) * sigmoidf_(z1[1]); o[6] = bf_lo(gw.w) * sigmoidf_(z1[2]); o[7] = bf_hi(gw.w) * sigmoidf_(z1[3]);
                    u32x4 w; w.x = cvt_pk_bf16(o[0], o[1]); w.y = cvt_pk_bf16(o[2], o[3]); w.z = cvt_pk_bf16(o[4], o[5]); w.w = cvt_pk_bf16(o[6], o[7]);
                    *(u32x4*)(O + ro + bj * HALF) = w; } }
    }
};
struct EpiGateUp {
    static constexpr bool PERM = true, AFTER_DRAIN = false;
    bf16_t* H; int ldh;
    __device__ __forceinline__ void operator()(const f32x4 (&acc)[2][2][4][2], const Unit& u, int wr, int wc, int fr, int fq) const {
        const int row0 = u.pm * BM + wr * 64 + fr, col0 = (u.pn * BM + wc * 32 + 8 * fq) >> 1;
#pragma unroll
        for (int ai = 0; ai < 2; ++ai)
#pragma unroll
            for (int m = 0; m < 4; ++m) { bf16_t* rowp = H + (size_t)(row0 + ai * HALF + m * 16) * ldh + col0;
#pragma unroll
                for (int bj = 0; bj < 2; ++bj) { const f32x4 g = acc[ai][bj][m][0], up = acc[ai][bj][m][1];
                    const float h0 = g[0] * sigmoidf_(g[0]) * up[0], h1 = g[1] * sigmoidf_(g[1]) * up[1], h2 = g[2] * sigmoidf_(g[2]) * up[2], h3 = g[3] * sigmoidf_(g[3]) * up[3];
                    u32x2 w; w.x = cvt_pk_bf16(h0, h1); w.y = cvt_pk_bf16(h2, h3);
                    *(u32x2*)(rowp + bj * (HALF / 2)) = w; } }
    }
};
struct EpiSoftmax {
    static constexpr bool PERM = true, AFTER_DRAIN = true;
    bf16_t* P; int ldc;
    __device__ __forceinline__ void fused(f32x4 (&acc)[2][2][4][2], const Unit& u, int wr, int wc, int fr, int fq, PG8_LAS unsigned char* lds, int wid, int lane) const {
        typedef float f32x2v __attribute__((ext_vector_type(2)));
        PG8_LAS f32x2v* T = (PG8_LAS f32x2v*)lds;
        float mxs[2][4];
#pragma unroll
        for (int ai = 0; ai < 2; ++ai)
#pragma unroll
            for (int m = 0; m < 4; ++m) {
                float mx = -3.0e38f;
#pragma unroll
                for (int bj = 0; bj < 2; ++bj)
#pragma unroll
                    for (int n = 0; n < 2; ++n) { const f32x4 x = acc[ai][bj][m][n]; mx = fmaxf(mx, fmaxf(fmaxf(x[0], x[1]), fmaxf(x[2], x[3]))); }
                mx = fmaxf(mx, __shfl_xor(mx, 16)); mx = fmaxf(mx, __shfl_xor(mx, 32));
                float s = 0.f;
#pragma unroll
                for (int bj = 0; bj < 2; ++bj)
#pragma unroll
                    for (int n = 0; n < 2; ++n) { f32x4 x = acc[ai][bj][m][n];
                        x[0] = __builtin_amdgcn_exp2f(x[0] - mx); x[1] = __builtin_amdgcn_exp2f(x[1] - mx); x[2] = __builtin_amdgcn_exp2f(x[2] - mx); x[3] = __builtin_amdgcn_exp2f(x[3] - mx);
                        s += (x[0] + x[1]) + (x[2] + x[3]); acc[ai][bj][m][n] = x; }
                s += __shfl_xor(s, 16); s += __shfl_xor(s, 32);
                mxs[ai][m] = mx;
                if (fq == 0) T[(ai * HALF + wr * 64 + m * 16 + fr) * 4 + wc] = (f32x2v){mx, s};
            }
        asm volatile("s_waitcnt lgkmcnt(0)" ::: "memory"); __builtin_amdgcn_s_barrier(); asm volatile("" ::: "memory");
        const int row0 = u.pm * BM + wr * 64 + fr, col0 = u.pn * BM + wc * 32 + 8 * fq;
#pragma unroll
        for (int ai = 0; ai < 2; ++ai)
#pragma unroll
            for (int m = 0; m < 4; ++m) {
                const int r = ai * HALF + wr * 64 + m * 16 + fr;
                const f32x2v a = T[r * 4 + 0], b = T[r * 4 + 1], c = T[r * 4 + 2], d = T[r * 4 + 3];
                const float Mx = fmaxf(fmaxf(a.x, b.x), fmaxf(c.x, d.x));
                const float tot = a.y * __builtin_amdgcn_exp2f(a.x - Mx) + b.y * __builtin_amdgcn_exp2f(b.x - Mx) + c.y * __builtin_amdgcn_exp2f(c.x - Mx) + d.y * __builtin_amdgcn_exp2f(d.x - Mx);
                const float sc = __builtin_amdgcn_exp2f(mxs[ai][m] - Mx) / tot;
                bf16_t* rowp = P + (size_t)(row0 + ai * HALF + m * 16) * ldc + col0;
#pragma unroll
                for (int bj = 0; bj < 2; ++bj) { const f32x4 v0 = acc[ai][bj][m][0] * sc, v1 = acc[ai][bj][m][1] * sc;
                    u32x4 w; w.x = cvt_pk_bf16(v0[0], v0[1]); w.y = cvt_pk_bf16(v0[2], v0[3]); w.z = cvt_pk_bf16(v1[0], v1[1]); w.w = cvt_pk_bf16(v1[2], v1[3]);
                    *(u32x4*)(rowp + bj * HALF) = w; }
            }
    }
};
struct PanelStats {
    unsigned* xbuf;
    unsigned* cnt;
    unsigned* tmo;
    int ntn; float eps;
    unsigned code;
    __device__ __forceinline__ bool run(const f32x4 (&v)[2][2][4][2], const Unit& u, int wr, int wc, int fr, int fq, PG8_LAS unsigned char* lds, int wid, int lane) const {
        typedef float f32x2v __attribute__((ext_vector_type(2)));
        PG8_LAS f32x2v* P = (PG8_LAS f32x2v*)lds;
        PG8_LAS f32x2v* S = (PG8_LAS f32x2v*)(lds + 8192);
        PG8_LAS unsigned* flag = (PG8_LAS unsigned*)(lds + 8192 + 2048);
#pragma unroll
        for (int ai = 0; ai < 2; ++ai)
#pragma unroll
            for (int m = 0; m < 4; ++m) {
                float s = 0.f;
#pragma unroll
                for (int bj = 0; bj < 2; ++bj)
#pragma unroll
                    for (int n = 0; n < 2; ++n) { const f32x4 x = v[ai][bj][m][n]; s += (x[0] + x[1]) + (x[2] + x[3]); }
                s += __shfl_xor(s, 16); s += __shfl_xor(s, 32);
                const float mw = s * (1.0f / 64.0f); float q = 0.f;
#pragma unroll
                for (int bj = 0; bj < 2; ++bj)
#pragma unroll
                    for (int n = 0; n < 2; ++n) { const f32x4 d = v[ai][bj][m][n] - mw; q += (d[0] * d[0] + d[1] * d[1]) + (d[2] * d[2] + d[3] * d[3]); }
                q += __shfl_xor(q, 16); q += __shfl_xor(q, 32);
                if (fq == 0) P[(ai * HALF + wr * 64 + m * 16 + fr) * 4 + wc] = (f32x2v){mw, q};
            }
        asm volatile("s_waitcnt lgkmcnt(0)" ::: "memory"); __builtin_amdgcn_s_barrier(); asm volatile("" ::: "memory");
#if defined(BROKEN_EXCHANGE_NO_WAIT)
#warning BROKEN CONTROL BUILD: the row-statistics exchange does not wait; results are wrong by design
        if (blockIdx.x >= 64) { const long long t0_ = clock64(); while (clock64() - t0_ < 60000) __builtin_amdgcn_s_sleep(8); }
#endif
        const int row = wid * 32 + (lane & 31);
        if (lane < 32) {
            const f32x2v a = P[row * 4 + 0], b = P[row * 4 + 1], c = P[row * 4 + 2], d = P[row * 4 + 3];
            const float mt = (a.x + b.x + c.x + d.x) * 0.25f;
            const float da = a.x - mt, db = b.x - mt, dc = c.x - mt, dd = d.x - mt;
            const float m2 = (a.y + b.y) + (c.y + d.y) + 64.0f * ((da * da + db * db) + (dc * dc + dd * dd));
            unsigned long long* slot = (unsigned long long*)xbuf + ((size_t)(u.pm * BM + row) * 4 + u.pn);
            __hip_atomic_store(slot, ((unsigned long long)__float_as_uint(m2) << 32) | __float_as_uint(mt), __ATOMIC_RELAXED, __HIP_MEMORY_SCOPE_AGENT);
        }
        asm volatile("s_waitcnt vmcnt(0)" ::: "memory");
        if (lane == 0) __hip_atomic_fetch_add(cnt + 64 * u.pm, 1u, __ATOMIC_RELAXED, __HIP_MEMORY_SCOPE_AGENT);
        if (wid == 0) {
            bool dead = false; const unsigned long long t0 = __builtin_amdgcn_s_memrealtime(); const unsigned want = 8u * (unsigned)ntn;
            for (;;) {
#if defined(BROKEN_EXCHANGE_NO_WAIT)
                break;
#endif
                if ((unsigned)__builtin_amdgcn_readfirstlane(__hip_atomic_load(cnt + 64 * u.pm, __ATOMIC_RELAXED, __HIP_MEMORY_SCOPE_AGENT)) >= want) break;
                if (__builtin_amdgcn_s_memrealtime() - t0 > 2000000ull) {
                    if (lane == 0) { unsigned expect = 0u; __hip_atomic_compare_exchange_strong(tmo + 1, &expect, code | (unsigned)(u.pm & 0xff), __ATOMIC_RELAXED, __ATOMIC_RELAXED, __HIP_MEMORY_SCOPE_AGENT);
                                     __hip_atomic_store(tmo, 1u, __ATOMIC_RELAXED, __HIP_MEMORY_SCOPE_AGENT); }
                    dead = true; break; }
                __builtin_amdgcn_s_sleep(2);
            }
            __builtin_amdgcn_fence(__ATOMIC_ACQUIRE, "agent");
            if (lane == 0) flag[0] = dead ? 1u : 0u;
        }
        asm volatile("s_waitcnt vmcnt(0) lgkmcnt(0)" ::: "memory"); __builtin_amdgcn_s_barrier(); asm volatile("" ::: "memory");
        const bool bad = flag[0] != 0u;
        if (lane < 32) {
            const unsigned long long* slot = (const unsigned long long*)xbuf + (size_t)(u.pm * BM + row) * 4; float mt[4], m2[4]; float ms = 0.f;
#pragma unroll
            for (int t = 0; t < 4; ++t) { if (t < ntn) { const unsigned long long w = __hip_atomic_load(slot + t, __ATOMIC_RELAXED, __HIP_MEMORY_SCOPE_AGENT); mt[t] = __uint_as_float((unsigned)w); m2[t] = __uint_as_float((unsigned)(w >> 32)); } else { mt[t] = 0.f; m2[t] = 0.f; } ms += mt[t]; }
            const float mean = ms / (float)ntn; float q = 0.f;
#pragma unroll
            for (int t = 0; t < 4; ++t) if (t < ntn) { const float dm = mt[t] - mean; q += m2[t] + 256.0f * dm * dm; }
            S[row] = (f32x2v){mean, 1.0f / sqrtf(q / (256.0f * (float)ntn) + eps)};
        }
        asm volatile("s_waitcnt lgkmcnt(0)" ::: "memory"); __builtin_amdgcn_s_barrier(); asm volatile("" ::: "memory");
        return bad;
    }
};
template <class Epi, class Sched, bool ALIGN_EPI = false, bool SP2 = false>
__device__ __forceinline__ void gemm_phase(PG8_LAS unsigned char* lds, const Gemm g, const Sched& S, const Epi& E) {
    const int tid = threadIdx.x, wid = __builtin_amdgcn_readfirstlane(tid >> 6), lane = tid & 63, wr = wid >> 2, wc = wid & 3, fr = lane & 15, fq = lane >> 4;
    const int K = g.K, nt = K / BK; const int lda = g.lda ? g.lda : K, ldb = g.ldb ? g.ldb : K;
    unsigned voffA[2], voffB[2];
#pragma unroll
    for (int i = 0; i < 2; ++i) { int R, C; stage_rc(tid * 16 + i * 8192, R, C); const int Rb = Epi::PERM ? ((R & ~31) + perm32(R & 31)) : R;
        voffA[i] = (unsigned)(R * lda + C) * 2u; voffB[i] = (unsigned)(Rb * ldb + C) * 2u; }
    const size_t kstep = (size_t)(BK * 2);
    const size_t hstepA = (size_t)HALF * lda * 2, hstepB = (size_t)HALF * ldb * 2;
    const unsigned ldsw = (unsigned)wid * 1024u;
    const int aoff = lds_byte(wr * 64 + fr, fq * 8), boff = lds_byte(wc * 32 + fr, fq * 8);
#define PG8_SA(b, h) (((b) * 2 + (h)) * HTB)
#define PG8_SB(b, h) ((4 + (b) * 2 + (h)) * HTB)
#define PG8_STAGE(bufoff, gbase, voff) do { _Pragma("unroll") for (int _i = 0; _i < 2; ++_i) \
        __builtin_amdgcn_global_load_lds((const unsigned*)((const char*)(gbase) + (voff)[_i]), (PG8_LAS unsigned*)(lds + (bufoff) + ldsw + _i * 8192), 16, 0, 0); } while (0)
#define PG8_LDA(dst, b, h) do { _Pragma("unroll") for (int m = 0; m < 4; ++m) _Pragma("unroll") for (int k = 0; k < 2; ++k) dst[m][k] = *(const PG8_LAS bf16x8*)(lds + PG8_SA(b, h) + aoff + m * 2048 + k * 1024); } while (0)
#define PG8_LDB(dst, b, h) do { _Pragma("unroll") for (int n = 0; n < 2; ++n) _Pragma("unroll") for (int k = 0; k < 2; ++k) dst[n][k] = *(const PG8_LAS bf16x8*)(lds + PG8_SB(b, h) + boff + n * 2048 + k * 1024); } while (0)
#define PG8_MMA(ai, bj, At, Bt) do { __builtin_amdgcn_s_setprio(1); _Pragma("unroll") for (int m = 0; m < 4; ++m) _Pragma("unroll") for (int n = 0; n < 2; ++n) _Pragma("unroll") for (int k = 0; k < 2; ++k) \
        acc[ai][bj][m][n] = __builtin_amdgcn_mfma_f32_16x16x32_bf16(Bt[n][k], At[m][k], acc[ai][bj][m][n], 0, 0, 0); __builtin_amdgcn_s_setprio(0); } while (0)
#define PG8_WAIT_V(n) asm volatile("s_waitcnt vmcnt(" #n ")" ::: "memory")
#define PG8_WAIT_L(n) asm volatile("s_waitcnt lgkmcnt(" #n ")" ::: "memory")
#define PG8_BAR __builtin_amdgcn_s_barrier()
#define PG8_SCHED __builtin_amdgcn_sched_barrier(0)
    Unit cur, nxt; int ui = 0;
    if (!S.next(0, cur)) return;
    f32x4 acc[2][2][4][2];
#pragma unroll
    for (int a = 0; a < 2; ++a)
#pragma unroll
        for (int b = 0; b < 2; ++b)
#pragma unroll
            for (int m = 0; m < 4; ++m)
#pragma unroll
                for (int n = 0; n < 2; ++n) acc[a][b][m][n] = (f32x4){0.f, 0.f, 0.f, 0.f};
    bf16x8 At[4][2], B0[2][2], B1[2][2];
    const char* cA = (const char*)g.A + S.a_off(cur, lda); const char* cB = (const char*)g.Bt + S.b_off(cur, ldb);
    S.a_ready(cur);
    if constexpr (SP2) {
        PG8_STAGE(PG8_SB(0, 0), cB, voffB); PG8_STAGE(PG8_SB(0, 1), cB + hstepB, voffB); PG8_STAGE(PG8_SA(0, 0), cA, voffA); PG8_STAGE(PG8_SA(0, 1), cA + hstepA, voffA);
        if (wr == 1) PG8_BAR;
        PG8_WAIT_V(2); PG8_BAR;
        PG8_STAGE(PG8_SB(1, 0), cB + kstep, voffB); PG8_STAGE(PG8_SA(1, 0), cA + kstep, voffA); PG8_STAGE(PG8_SB(1, 1), cB + hstepB + kstep, voffB);
        PG8_WAIT_V(6); PG8_BAR;
    } else {
        PG8_STAGE(PG8_SB(0, 0), cB, voffB); PG8_STAGE(PG8_SA(0, 0), cA, voffA); PG8_STAGE(PG8_SB(0, 1), cB + hstepB, voffB); PG8_STAGE(PG8_SA(0, 1), cA + hstepA, voffA);
        if (wr == 1) PG8_BAR;
        PG8_WAIT_V(4); PG8_BAR;
        PG8_STAGE(PG8_SB(1, 0), cB + kstep, voffB); PG8_STAGE(PG8_SA(1, 0), cA + kstep, voffA); PG8_STAGE(PG8_SB(1, 1), cB + hstepB + kstep, voffB);
        PG8_WAIT_V(6); PG8_BAR;
    }
    for (;;) {
        const bool has_next = S.next(ui + 1, nxt);
        const char* nA = has_next ? (const char*)g.A + S.a_off(nxt, lda) : cA; const char* nB = has_next ? (const char*)g.Bt + S.b_off(nxt, ldb) : cB;
        for (int t = 0; t < nt; t += 2) {
            const bool last = (t == nt - 2);
            const char* a1 = cA + (size_t)(t + 1) * kstep;
            const char* a2 = last ? nA : cA + (size_t)(t + 2) * kstep; const char* b2 = last ? nB : cB + (size_t)(t + 2) * kstep;
            const char* a3 = a2 + kstep; const char* b3 = b2 + kstep;
            if (last && has_next) S.a_ready(nxt);
            if constexpr (SP2) {
            PG8_LDB(B0, 0, 0); PG8_LDB(B1, 0, 1); PG8_SCHED; PG8_LDA(At, 0, 0); PG8_STAGE(PG8_SA(1, 1), a1 + hstepA, voffA);
            PG8_WAIT_V(8); PG8_WAIT_L(0); PG8_BAR; PG8_MMA(0, 0, At, B0); PG8_MMA(0, 1, At, B1); PG8_BAR; PG8_SCHED;
            PG8_LDA(At, 0, 1); PG8_STAGE(PG8_SB(0, 0), b2, voffB); PG8_STAGE(PG8_SB(0, 1), b2 + hstepB, voffB); PG8_STAGE(PG8_SA(0, 0), a2, voffA);
            PG8_WAIT_V(8); PG8_WAIT_L(0); PG8_BAR; PG8_MMA(1, 0, At, B0); PG8_MMA(1, 1, At, B1); PG8_BAR; PG8_SCHED;
            PG8_LDB(B0, 1, 0); PG8_LDB(B1, 1, 1); PG8_SCHED; PG8_LDA(At, 1, 0); PG8_STAGE(PG8_SA(0, 1), a2 + hstepA, voffA);
            PG8_WAIT_V(8); PG8_WAIT_L(0); PG8_BAR; PG8_MMA(0, 0, At, B0); PG8_MMA(0, 1, At, B1); PG8_BAR; PG8_SCHED;
            PG8_LDA(At, 1, 1); PG8_STAGE(PG8_SB(1, 0), b3, voffB); PG8_STAGE(PG8_SB(1, 1), b3 + hstepB, voffB); PG8_STAGE(PG8_SA(1, 0), a3, voffA);
            PG8_WAIT_V(8); PG8_WAIT_L(0); PG8_BAR; PG8_MMA(1, 0, At, B0); PG8_MMA(1, 1, At, B1); PG8_BAR; PG8_SCHED;
            } else {
            PG8_LDB(B0, 0, 0); PG8_SCHED; PG8_LDA(At, 0, 0); PG8_STAGE(PG8_SA(1, 1), a1 + hstepA, voffA);
            PG8_WAIT_L(8); PG8_BAR; PG8_WAIT_L(0); PG8_MMA(0, 0, At, B0); PG8_BAR; PG8_SCHED;
            PG8_LDB(B1, 0, 1); PG8_STAGE(PG8_SB(0, 0), b2, voffB);
            PG8_BAR; PG8_WAIT_L(0); PG8_MMA(0, 1, At, B1); PG8_BAR;
            PG8_LDA(At, 0, 1); PG8_STAGE(PG8_SA(0, 0), a2, voffA);
            PG8_BAR; PG8_WAIT_L(0); PG8_MMA(1, 0, At, B0); PG8_BAR; PG8_SCHED;
            PG8_STAGE(PG8_SB(0, 1), b2 + hstepB, voffB);
            PG8_WAIT_V(6); PG8_BAR; PG8_MMA(1, 1, At, B1); PG8_BAR;
            PG8_LDB(B0, 1, 0); PG8_SCHED; PG8_LDA(At, 1, 0); PG8_STAGE(PG8_SA(0, 1), a2 + hstepA, voffA);
            PG8_WAIT_L(8); PG8_BAR; PG8_WAIT_L(0); PG8_MMA(0, 0, At, B0); PG8_BAR; PG8_SCHED;
            PG8_LDB(B1, 1, 1); PG8_STAGE(PG8_SB(1, 0), b3, voffB);
            PG8_BAR; PG8_WAIT_L(0); PG8_MMA(0, 1, At, B1); PG8_BAR;
            PG8_LDA(At, 1, 1); PG8_STAGE(PG8_SA(1, 0), a3, voffA);
            PG8_BAR; PG8_WAIT_L(0); PG8_MMA(1, 0, At, B0); PG8_BAR; PG8_SCHED;
            PG8_STAGE(PG8_SB(1, 1), b3 + hstepB, voffB);
            PG8_WAIT_V(6); PG8_BAR; PG8_MMA(1, 1, At, B1); PG8_BAR;
            }
        }
        if constexpr (ALIGN_EPI) { if (wr == 0) PG8_BAR; }
        if constexpr (!Epi::AFTER_DRAIN) { E(acc, cur, wr, wc, fr, fq); S.done(cur); }
        if (!has_next) break;
#pragma unroll
        for (int a = 0; a < 2; ++a)
#pragma unroll
            for (int b = 0; b < 2; ++b)
#pragma unroll
                for (int m = 0; m < 4; ++m)
#pragma unroll
                    for (int n = 0; n < 2; ++n) acc[a][b][m][n] = (f32x4){0.f, 0.f, 0.f, 0.f};
        cur = nxt; cA = nA; cB = nB; ++ui;
        if constexpr (ALIGN_EPI) { if (wr == 1) PG8_BAR; }
    }
    PG8_WAIT_V(0);
    if constexpr (!ALIGN_EPI) { if (wr == 0) PG8_BAR; }
    PG8_BAR;
    if constexpr (Epi::AFTER_DRAIN) { E.fused(acc, cur, wr, wc, fr, fq, lds, wid, lane); S.done(cur); }
#undef PG8_SA
#undef PG8_SB
#undef PG8_STAGE
#undef PG8_LDA
#undef PG8_LDB
#undef PG8_MMA
#undef PG8_WAIT_V
#undef PG8_WAIT_L
#undef PG8_BAR
#undef PG8_SCHED
}
}
constexpr int NWAVES = 8;
constexpr int DM = 1024, SEQ = 2048, NB = 8, DB = 128, DT = 4, WBUF = 2048;
constexpr int MP = NB * SEQ, MS = DB * DT, M = MP + MS;
constexpr int DATT = 512, DSSM = 512, DIN = 2048, DFF = 2816, NMEM = 256, MM = NB * NMEM;
constexpr int NG = 32, NP = 64, NCH = 16, NH = 8, HD = 64;
constexpr float LN_EPS = 1e-5f, ALPHA = 1.189207115002721f;
constexpr float QSCALE = 0.125f * 1.4426950408889634f;
constexpr float MQSCALE = 0.0625f * 1.4426950408889634f;
constexpr size_t O_YP = 0, O_YS = 16777216, O_WKP = 17301504, O_WVP = 25690112, O_WKS = 34078720, O_WVS = 34340864, O_SRP = 34603008, O_SIP = 34619392,
                 O_SRS = 34635776, O_SIS = 34897920, O_MKP = 35160064, O_MVP = 37257216, O_END = 39354368;
enum { I_XP = 0, I_XS, I_CWK, I_CWV, I_SRE, I_SIM, I_CMK, I_CMV, I_MEMP, I_WIN, I_GATT, I_GSSM, I_ARE, I_AIM, I_LDT, I_BRE, I_BIM, I_CRE, I_CIM, I_DSK, I_WGLU, I_BGLU, I_WOUT,
       I_LN1G, I_LN1B, I_WMQ, I_WMK, I_WMV, I_WMO, I_LN2G, I_LN2B, I_WGATE, I_WUP, I_WDOWN, I_LN3G, I_LN3B, N_IN };
constexpr size_t MiB = 1u << 20;
constexpr size_t al(size_t x) { return (x + 4095) & ~(size_t)4095; }
constexpr size_t WS_CTL = 0, CTL_ZERO_BYTES = 1 * MiB;
constexpr size_t WS_WIN = 2 * MiB;
constexpr size_t WS_WGLU = WS_WIN + al((size_t)DIN * DM * 2);
constexpr size_t WS_WOUT = WS_WGLU + al((size_t)DSSM * DSSM * 2);
constexpr size_t WS_WMQ = WS_WOUT + al((size_t)DM * DM * 2);
constexpr size_t WS_WMKV = WS_WMQ + al((size_t)DM * DM * 2);
constexpr size_t WS_WMO = WS_WMKV + al((size_t)2 * DM * DM * 2);
constexpr size_t WS_WGU = WS_WMO + al((size_t)DM * DM * 2);
constexpr size_t WS_WDN = WS_WGU + al((size_t)2 * DFF * DM * 2);
constexpr size_t WS_XB = WS_WDN + al((size_t)DM * DFF * 2);
constexpr size_t WS_MPB = WS_XB + al((size_t)M * DM * 2);
constexpr size_t WS_QB = WS_MPB + al((size_t)MM * DM * 2);
constexpr size_t WS_KB = WS_QB + al((size_t)M * 512 * 2);
constexpr size_t WS_VB = WS_KB + al((size_t)M * 512 * 2);
constexpr size_t WS_UB = WS_VB + al((size_t)M * 512 * 2);
constexpr size_t WS_MKB = WS_UB + al((size_t)M * 512 * 2);
constexpr size_t WS_MVB = WS_MKB + al((size_t)MM * DM * 2);
constexpr size_t WS_ATT = WS_MVB + al((size_t)MM * DM * 2);
constexpr size_t WS_GB = WS_ATT + al((size_t)M * 512 * 2);
constexpr size_t WS_YS = WS_GB + al((size_t)M * 512 * 2);
constexpr size_t WS_A2 = WS_YS + al((size_t)M * 512 * 2);
constexpr size_t WS_PRE = WS_A2 + al((size_t)M * DM * 2);
constexpr size_t WS_X1 = WS_PRE + al((size_t)M * DM * 4);
constexpr size_t WS_X1B = WS_X1 + al((size_t)M * DM * 4);
constexpr size_t WS_X2 = WS_X1B + al((size_t)M * DM * 2);
constexpr size_t WS_X2B = WS_X2 + al((size_t)M * DM * 4);
constexpr size_t WS_QM = WS_X2B + al((size_t)M * DM * 2);
constexpr size_t WS_OM = WS_QM + al((size_t)M * DM * 2);
constexpr size_t WS_H = WS_OM + al((size_t)M * DM * 2);
constexpr size_t WS_STAB = WS_H + al((size_t)M * DFF * 2);
constexpr size_t WS_SEG = WS_STAB + al(1 * MiB);
constexpr size_t WS_MVT = WS_SEG + al(1 * MiB);
constexpr size_t WS_PB = WS_MVT + al((size_t)DM * MM * 2);
constexpr size_t WS_END = WS_PB + al((size_t)MP * DM * 2);
enum { PH_PRO = 0, PH_IN, PH_ATT, PH_SSM, PH_GLU, PH_MIX, PH_WOUT, PH_LN1, PH_MQ, PH_MA1, PH_MA2, PH_MO, PH_LN2, PH_GU, PH_DN, PH_LN3, PH_N };
constexpr int CW_TMO = 0, CW_CODE = 1, CW_BAR = 4096;

constexpr int RING_OFF = 0, RING_BYTES = 131072;
constexpr int LDSCTL_OFF = RING_BYTES, MISC_OFF = LDSCTL_OFF + 320;
constexpr int LDS_BYTES = 147456;

#define GAS __attribute__((address_space(1)))
#define LAS __attribute__((address_space(3)))
typedef unsigned short bf16;
typedef unsigned v4u __attribute__((ext_vector_type(4)));
typedef float f32x4 __attribute__((ext_vector_type(4)));
typedef short bf16x8 __attribute__((ext_vector_type(8)));
typedef GAS unsigned gu32;
typedef GAS unsigned long long gu64;
#define RLX_AGENT __ATOMIC_RELAXED, __HIP_MEMORY_SCOPE_AGENT
#define LDS_WAIT() asm volatile("s_waitcnt lgkmcnt(0)" ::: "memory")
#define VM_WAIT() asm volatile("s_waitcnt vmcnt(0)" ::: "memory")
__device__ __forceinline__ unsigned long long rt() { return __builtin_amdgcn_s_memrealtime(); }
__device__ __forceinline__ unsigned f2bf(float f) { unsigned u = __builtin_bit_cast(unsigned, f); return (u + 0x7fffu + ((u >> 16) & 1u)) >> 16; }
__device__ __forceinline__ unsigned pk2(float lo, float hi) { return f2bf(lo) | (f2bf(hi) << 16); }

#define XB_TMO      128
#define XB_XCNT(j)  (256  + 64 * (j))
#define XB_XSUB(j)  (1280 + 64 * (j))
#define XB_XGEN(j)  (2304 + 64 * (j))
#define XB_TOP      3328
#define XB_TOPGEN   3392
#define XCD_BAR_WORDS 3456
#define XB_SPIN_CAP (1u << 18)

__device__ __forceinline__ unsigned xb_ld(unsigned* p)              { return __hip_atomic_load(p, __ATOMIC_RELAXED, __HIP_MEMORY_SCOPE_AGENT); }
__device__ __forceinline__ unsigned xb_add(unsigned* p, unsigned v) { return __hip_atomic_fetch_add(p, v, __ATOMIC_RELAXED, __HIP_MEMORY_SCOPE_AGENT); }
__device__ __forceinline__ unsigned xb_xcc_id() { return (unsigned)__builtin_amdgcn_s_getreg((3 << 11) | 20) & 0xFu; }
#define XB_SPIN(cond, bar) do { unsigned _sp = 0; while (cond) { __builtin_amdgcn_s_sleep(1); \
    if ((++_sp & 255u) == 0u) { if (xb_ld(&(bar)[XB_TMO])) break; if (_sp > XB_SPIN_CAP) { atomicAdd(&(bar)[XB_TMO], 1u); break; } } } } while (0)

struct XcdBarrier {
    unsigned* bar; unsigned x;
    volatile LAS unsigned* st;
};

__device__ __forceinline__ XcdBarrier xcd_barrier_post(unsigned* bar, volatile LAS unsigned* st) {
    XcdBarrier b; b.bar = bar; b.x = xb_xcc_id(); b.st = st;
    if (threadIdx.x == 0) (void)xb_add(&bar[XB_XCNT(b.x)], 1u);
    return b;
}
__device__ __forceinline__ void xcd_barrier_complete(unsigned* bar, unsigned x, unsigned& nloc, unsigned& nx) {
    const unsigned G = gridDim.x * gridDim.y * gridDim.z;
    unsigned sum, cnt, mine, sp = 0u;
    for (;;) {
        sum = 0u; cnt = 0u; mine = 0u;
#pragma unroll
        for (unsigned j = 0; j < 16; ++j) { const unsigned c = xb_ld(&bar[XB_XCNT(j)]); sum += c; cnt += (c > 0u) ? 1u : 0u; mine = (j == x) ? c : mine; }
        if (sum == G) break;
        __builtin_amdgcn_s_sleep(1);
        if ((++sp & 255u) == 0u) { if (xb_ld(&bar[XB_TMO])) break; if (sp > XB_SPIN_CAP) { atomicAdd(&bar[XB_TMO], 1u); break; } }
    }
    nloc = mine > 0u ? mine : 1u; nx = cnt > 0u ? cnt : 1u;
}

__device__ __forceinline__ void xcd_barrier(const XcdBarrier& b) {
    asm volatile("s_waitcnt vmcnt(0)" ::: "memory");
    __syncthreads();
    if (threadIdx.x == 0) {
        unsigned* bar = b.bar;
        __builtin_amdgcn_s_waitcnt(0);
        unsigned nloc = b.st[0], nx = b.st[1];
        if (nloc == 0u) { xcd_barrier_complete(bar, b.x, nloc, nx); b.st[0] = nloc; b.st[1] = nx; }
        const unsigned old = xb_add(&bar[XB_XSUB(b.x)], 1u);
        const unsigned gen = old / nloc;
        if (old + 1u == (gen + 1u) * nloc) {
            __builtin_amdgcn_fence(__ATOMIC_RELEASE, "agent");
            asm volatile("s_waitcnt vmcnt(0)" ::: "memory");
            const unsigned og = xb_add(&bar[XB_TOP], 1u);
            const unsigned tg = og / nx;
            if (og + 1u == (tg + 1u) * nx) xb_add(&bar[XB_TOPGEN], 1u);
            else XB_SPIN(xb_ld(&bar[XB_TOPGEN]) == tg, bar);
            __builtin_amdgcn_fence(__ATOMIC_ACQUIRE, "agent");
            xb_add(&bar[XB_XGEN(b.x)], 1u);
            asm volatile("s_waitcnt vmcnt(0)" ::: "memory");
        } else {
            XB_SPIN(xb_ld(&bar[XB_XGEN(b.x)]) == gen, bar);
            __builtin_amdgcn_fence(__ATOMIC_ACQUIRE, "agent");
            asm volatile("s_waitcnt vmcnt(0)" ::: "memory");
        }
    }
    __syncthreads();
}
__device__ __forceinline__ float bf2f(bf16 b) { return __uint_as_float((unsigned)b << 16); }
__device__ __forceinline__ float wave_sum(float v) {
#pragma unroll
    for (int o = 1; o < 64; o <<= 1) v += __shfl_xor(v, o);
    return v;
}
struct Args { const float* in[N_IN]; float* out; unsigned char* ws; int ph_lo, ph_hi, li, pad; };

template <int MODE>
__device__ __forceinline__ void p0_transpose_item(const float* W, int K, int N, bf16* WT, int row_off, LAS float* scr, int item, int lane) {
    const int nblk = N / 32, kb = item / nblk, nb = item % nblk, k0 = 64 * kb, n0 = 32 * nb;
#pragma unroll 8
    for (int i = 0; i < 32; ++i) { const int kk = 2 * i + (lane >> 5); scr[kk * 33 + (lane & 31)] = W[(size_t)(k0 + kk) * N + n0 + (lane & 31)]; }
    LDS_WAIT(); asm volatile("" ::: "memory");
    const int c = lane & 7;
#pragma unroll
    for (int j = 0; j < 4; ++j) { const int n = (lane >> 3) + 8 * j; const LAS float* s = scr + (8 * c) * 33 + n;
        v4u o; o.x = pk2(s[0 * 33], s[1 * 33]); o.y = pk2(s[2 * 33], s[3 * 33]); o.z = pk2(s[4 * 33], s[5 * 33]); o.w = pk2(s[6 * 33], s[7 * 33]);
        const int nn = n0 + n; const int drow = (MODE == 0) ? (row_off + nn) : (8 * (nn >> 2) + (nn & 3) + row_off);
        *(GAS v4u*)(WT + (size_t)drow * K + k0 + 8 * c) = o; }
    LDS_WAIT(); asm volatile("" ::: "memory");
}
__device__ __forceinline__ void p0_convert(const float* src, bf16* dst, size_t n8, size_t gt, size_t ngt) {
    for (size_t i = gt; i < n8; i += ngt) {
        const f32x4 a = ((const GAS f32x4*)src)[2 * i], b = ((const GAS f32x4*)src)[2 * i + 1];
        v4u o; o.x = pk2(a.x, a.y); o.y = pk2(a.z, a.w); o.z = pk2(b.x, b.y); o.w = pk2(b.z, b.w);
        ((GAS v4u*)dst)[i] = o;
    }
}

namespace att {
typedef float f32x16 __attribute__((ext_vector_type(16)));
typedef float f32x2_t __attribute__((ext_vector_type(2)));
typedef __bf16 bf16x2_t __attribute__((ext_vector_type(2)));
typedef short s16x4 __attribute__((ext_vector_type(4)));
typedef short v4i16_t __attribute__((ext_vector_type(4)));
constexpr int VSTR = 192, VT_BYTES = 32 * VSTR;
constexpr int CB_OFF = 8 * VT_BYTES, CL_OFF = CB_OFF + 512 * 128, LDS_END = CL_OFF + 512 * 4;
__device__ __forceinline__ int crow(int r, int hi) { return (r & 3) + 8 * (r >> 2) + 4 * hi; }
__device__ __forceinline__ unsigned cvtpk(float lo, float hi) { f32x2_t v = {lo, hi}; bf16x2_t b = __builtin_convertvector(v, bf16x2_t); return __builtin_bit_cast(unsigned, b); }
__device__ __forceinline__ s16x4 vtr(const LAS unsigned char* p) { return __builtin_bit_cast(s16x4, __builtin_amdgcn_ds_read_tr16_b64_v4i16((LAS v4i16_t*)p)); }

__device__ __forceinline__ void attn_prompt_unit(int b, int h, int c, const bf16* QB, const bf16* KB, const bf16* VB, bf16* ATT, LAS unsigned char* lds, int wave, int lane) {
    const int r32 = lane & 31, hi = lane >> 5;
    LAS unsigned char* vt = lds + wave * VT_BYTES;
    LAS unsigned char* CB = lds + CB_OFF; LAS float* CL = (LAS float*)(lds + CL_OFF);
    const LAS unsigned char* vtr0 = vt + (4 * hi + ((lane & 15) >> 2)) * VSTR + (((lane >> 4) & 1) * 16 + (lane & 3) * 4) * 2;
    const size_t rowb = (size_t)b * SEQ;
    for (int cfg = 0; cfg < 3; ++cfg) {
        const int d = (cfg == 0) ? 16 : (cfg == 1 ? 4 : 1);
        for (int tk = 0; tk < 2; ++tk) {
            const int j = wave * 2 + tk;
            int rho, i0;
            if (cfg == 0) { rho = j; i0 = 32 * c; } else if (cfg == 1) { rho = j & 3; i0 = 128 * c + 32 * (j >> 2); } else { rho = 0; i0 = 512 * c + 32 * j; }
            const int pq = d * (i0 + r32) + rho;
            const bf16* qp = QB + (rowb + pq) * 512 + h * 64 + 8 * hi;
            bf16x8 qf[4];
#pragma unroll
            for (int s = 0; s < 4; ++s) qf[s] = *(const bf16x8*)(qp + 16 * s);
            float m = -1e30f, l = 0.f; f32x16 o0, o1;
#pragma unroll
            for (int r = 0; r < 16; ++r) { o0[r] = 0.f; o1[r] = 0.f; }
            const int kt0 = (i0 >= 128) ? 0 : ((128 - i0) >> 5);
            for (int kt = kt0; kt < 5; ++kt) {
                const int kb = i0 - 128 + 32 * kt;
                const bf16* kp = KB + (rowb + d * (kb + r32) + rho) * 512 + h * 64 + 8 * hi;
                bf16x8 kf[4];
#pragma unroll
                for (int s = 0; s < 4; ++s) kf[s] = *(const bf16x8*)(kp + 16 * s);
                pg8::u32x4 vv[4];
#pragma unroll
                for (int i = 0; i < 4; ++i) vv[i] = *(const pg8::u32x4*)(VB + (rowb + d * (kb + (lane >> 3) + 8 * i) + rho) * 512 + h * 64 + 8 * (lane & 7));
#pragma unroll
                for (int i = 0; i < 4; ++i) *(LAS pg8::u32x4*)(vt + ((lane >> 3) + 8 * i) * VSTR + (lane & 7) * 16) = vv[i];
                f32x16 p;
#pragma unroll
                for (int r = 0; r < 16; ++r) p[r] = 0.f;
#pragma unroll
                for (int s = 0; s < 4; ++s) p = __builtin_amdgcn_mfma_f32_32x32x16_bf16(kf[s], qf[s], p, 0, 0, 0);
                if (kt == 0) {
#pragma unroll
                    for (int r = 0; r < 16; ++r) if (crow(r, hi) < r32) p[r] = -1e30f; }
                if (kt == 4) {
#pragma unroll
                    for (int r = 0; r < 16; ++r) if (crow(r, hi) > r32) p[r] = -1e30f; }
                float mx = p[0];
#pragma unroll
                for (int r = 1; r < 16; ++r) mx = fmaxf(mx, p[r]);
                mx = fmaxf(mx, __shfl_xor(mx, 32));
                const float mn = fmaxf(m, mx), corr = __builtin_amdgcn_exp2f(m - mn); m = mn;
                float ps = 0.f;
#pragma unroll
                for (int r = 0; r < 16; ++r) { p[r] = __builtin_amdgcn_exp2f(p[r] - mn); ps += p[r]; }
                l = l * corr + ps;
#pragma unroll
                for (int r = 0; r < 16; ++r) { o0[r] *= corr; o1[r] *= corr; }
                pg8::u32x4 pw0, pw1;
                pw0.x = cvtpk(p[0], p[1]); pw0.y = cvtpk(p[2], p[3]); pw0.z = cvtpk(p[4], p[5]); pw0.w = cvtpk(p[6], p[7]);
                pw1.x = cvtpk(p[8], p[9]); pw1.y = cvtpk(p[10], p[11]); pw1.z = cvtpk(p[12], p[13]); pw1.w = cvtpk(p[14], p[15]);
                const bf16x8 pb0 = __builtin_bit_cast(bf16x8, pw0), pb1 = __builtin_bit_cast(bf16x8, pw1);
#pragma unroll
                for (int s = 0; s < 2; ++s) {
                    const s16x4 a0l = vtr(vtr0 + (16 * s) * VSTR), a0h = vtr(vtr0 + (16 * s + 8) * VSTR);
                    const s16x4 a1l = vtr(vtr0 + (16 * s) * VSTR + 64), a1h = vtr(vtr0 + (16 * s + 8) * VSTR + 64);
                    const bf16x8 A0 = (bf16x8){a0l[0], a0l[1], a0l[2], a0l[3], a0h[0], a0h[1], a0h[2], a0h[3]};
                    const bf16x8 A1 = (bf16x8){a1l[0], a1l[1], a1l[2], a1l[3], a1h[0], a1h[1], a1h[2], a1h[3]};
                    o0 = __builtin_amdgcn_mfma_f32_32x32x16_bf16(A0, s == 0 ? pb0 : pb1, o0, 0, 0, 0);
                    o1 = __builtin_amdgcn_mfma_f32_32x32x16_bf16(A1, s == 0 ? pb0 : pb1, o1, 0, 0, 0);
                }
            }
            l += __shfl_xor(l, 32);
            const int ql = pq - 512 * c;
            float lse = m + __builtin_amdgcn_logf(l);
            float wc_ = 1.f, wp_ = 0.f;
            if (cfg > 0) { const float lp = CL[ql]; const float M2 = fmaxf(m, lp); wc_ = __builtin_amdgcn_exp2f(m - M2); wp_ = __builtin_amdgcn_exp2f(lp - M2);
                const float ln = l * wc_ + wp_; lse = M2 + __builtin_amdgcn_logf(ln); wc_ = wc_ / ln; wp_ = wp_ / ln; }
            else wc_ = 1.f / l;
            LAS unsigned char* cbq = CB + ql * 128 + 8 * hi;
            bf16* gq = ATT + (rowb + pq) * 512 + h * 64 + 4 * hi;
#pragma unroll
            for (int db = 0; db < 2; ++db)
#pragma unroll
                for (int g4 = 0; g4 < 4; ++g4) {
                    float v[4];
#pragma unroll
                    for (int e = 0; e < 4; ++e) v[e] = (db == 0 ? o0[4 * g4 + e] : o1[4 * g4 + e]) * wc_;
                    if (cfg > 0) { const pg8::u32x2 pv = *(const LAS pg8::u32x2*)(cbq + (32 * db + 8 * g4) * 2);
                        v[0] += wp_ * pg8::bf_lo(pv.x); v[1] += wp_ * pg8::bf_hi(pv.x); v[2] += wp_ * pg8::bf_lo(pv.y); v[3] += wp_ * pg8::bf_hi(pv.y); }
                    pg8::u32x2 w; w.x = cvtpk(v[0], v[1]); w.y = cvtpk(v[2], v[3]);
                    if (cfg < 2) *(LAS pg8::u32x2*)(cbq + (32 * db + 8 * g4) * 2) = w;
                    else *(pg8::u32x2*)(gq + 32 * db + 8 * g4) = w;
                }
            if (cfg < 2 && hi == 0) CL[ql] = lse;
        }
        __syncthreads();
    }
}

__device__ __forceinline__ void attn_sample_unit(int b, int hg, const bf16* QB, const bf16* KB, const bf16* VB, const float* ck, const float* cv, bf16* ATT, LAS unsigned char* lds, int wave, int lane) {
    const int r32 = lane & 31, hi = lane >> 5, h = 4 * hg + (wave & 3), half = wave >> 2, t = r32 & 3;
    LAS unsigned char* vt = lds + wave * VT_BYTES;
    LAS float* XC = (LAS float*)(lds + 8 * VT_BYTES) + (wave & 3) * (64 * 34);
    const LAS unsigned char* vtr0 = vt + (4 * hi + ((lane & 15) >> 2)) * VSTR + (((lane >> 4) & 1) * 16 + (lane & 3) * 4) * 2;
    const bf16* qp = QB + ((size_t)MP + b * 4 + t) * 512 + h * 64 + 8 * hi;
    bf16x8 qf[4];
#pragma unroll
    for (int s = 0; s < 4; ++s) qf[s] = *(const bf16x8*)(qp + 16 * s);
    float m = -1e30f, l = 0.f; f32x16 o0, o1;
#pragma unroll
    for (int r = 0; r < 16; ++r) { o0[r] = 0.f; o1[r] = 0.f; }
    const size_t cbase = (size_t)b * WBUF * 512 + h * 64;
    for (int it = 0; it < 15; ++it) {
        const int tile = half * 14 + it;
        if (it == 14 && half == 0) break;
        bf16x8 kf[4];
        if (it < 14) {
            const int krow = tile < 16 ? 1536 + 32 * tile + r32 : 16 * (8 * (tile - 16) + (r32 >> 2)) + (r32 & 3);
            const float* kp = ck + cbase + (size_t)krow * 512 + 8 * hi;
            pg8::f32x4 ka[4][2];
#pragma unroll
            for (int s = 0; s < 4; ++s) { ka[s][0] = *(const pg8::f32x4*)(kp + 16 * s); ka[s][1] = *(const pg8::f32x4*)(kp + 16 * s + 4); }
            pg8::f32x4 va[8];
#pragma unroll
            for (int i = 0; i < 8; ++i) { const int kk = (lane >> 4) + 4 * i; const int vrow = tile < 16 ? 1536 + 32 * tile + kk : 16 * (8 * (tile - 16) + (kk >> 2)) + (kk & 3);
                va[i] = *(const pg8::f32x4*)(cv + cbase + (size_t)vrow * 512 + 4 * (lane & 15)); }
#pragma unroll
            for (int s = 0; s < 4; ++s) { pg8::u32x4 w; w.x = cvtpk(ka[s][0][0], ka[s][0][1]); w.y = cvtpk(ka[s][0][2], ka[s][0][3]); w.z = cvtpk(ka[s][1][0], ka[s][1][1]); w.w = cvtpk(ka[s][1][2], ka[s][1][3]); kf[s] = __builtin_bit_cast(bf16x8, w); }
#pragma unroll
            for (int i = 0; i < 8; ++i) { pg8::u32x2 w; w.x = cvtpk(va[i][0], va[i][1]); w.y = cvtpk(va[i][2], va[i][3]); *(LAS pg8::u32x2*)(vt + ((lane >> 4) + 4 * i) * VSTR + (lane & 15) * 8) = w; }
        } else {
            const bf16* kp = KB + ((size_t)MP + b * 4 + (r32 & 3)) * 512 + h * 64 + 8 * hi;
#pragma unroll
            for (int s = 0; s < 4; ++s) kf[s] = *(const bf16x8*)(kp + 16 * s);
            const pg8::u32x4 vv = *(const pg8::u32x4*)(VB + ((size_t)MP + b * 4 + ((lane >> 3) & 3)) * 512 + h * 64 + 8 * (lane & 7));
#pragma unroll
            for (int i = 0; i < 4; ++i) *(LAS pg8::u32x4*)(vt + ((lane >> 3) + 8 * i) * VSTR + (lane & 7) * 16) = vv;
        }
        f32x16 p;
#pragma unroll
        for (int r = 0; r < 16; ++r) p[r] = 0.f;
#pragma unroll
        for (int s = 0; s < 4; ++s) p = __builtin_amdgcn_mfma_f32_32x32x16_bf16(kf[s], qf[s], p, 0, 0, 0);
        float mult[16];
#pragma unroll
        for (int r = 0; r < 16; ++r) { const int kk = crow(r, hi); int mu;
            if (it == 14) mu = (kk < 4) ? ((kk <= t ? 1 : 0) + (kk == t ? 2 : 0)) : 0;
            else if (tile >= 16) mu = ((kk & 3) == t) ? 1 : 0;
            else { const int rr = 1536 + 32 * tile + kk; mu = (rr >= 1920 + t ? 1 : 0) + ((rr & 3) == t ? 1 : 0) + ((rr & 15) == t ? 1 : 0); }
            mult[r] = (float)mu; if (mu == 0) p[r] = -1e30f; }
        float mx = p[0];
#pragma unroll
        for (int r = 1; r < 16; ++r) mx = fmaxf(mx, p[r]);
        mx = fmaxf(mx, __shfl_xor(mx, 32));
        const float mn = fmaxf(m, mx), corr = __builtin_amdgcn_exp2f(m - mn); m = mn;
        float ps = 0.f;
#pragma unroll
        for (int r = 0; r < 16; ++r) { p[r] = __builtin_amdgcn_exp2f(p[r] - mn) * mult[r]; ps += p[r]; }
        l = l * corr + ps;
#pragma unroll
        for (int r = 0; r < 16; ++r) { o0[r] *= corr; o1[r] *= corr; }
        pg8::u32x4 pw0, pw1;
        pw0.x = cvtpk(p[0], p[1]); pw0.y = cvtpk(p[2], p[3]); pw0.z = cvtpk(p[4], p[5]); pw0.w = cvtpk(p[6], p[7]);
        pw1.x = cvtpk(p[8], p[9]); pw1.y = cvtpk(p[10], p[11]); pw1.z = cvtpk(p[12], p[13]); pw1.w = cvtpk(p[14], p[15]);
        const bf16x8 pb0 = __builtin_bit_cast(bf16x8, pw0), pb1 = __builtin_bit_cast(bf16x8, pw1);
#pragma unroll
        for (int s = 0; s < 2; ++s) {
            const s16x4 a0l = vtr(vtr0 + (16 * s) * VSTR), a0h = vtr(vtr0 + (16 * s + 8) * VSTR);
            const s16x4 a1l = vtr(vtr0 + (16 * s) * VSTR + 64), a1h = vtr(vtr0 + (16 * s + 8) * VSTR + 64);
            const bf16x8 A0 = (bf16x8){a0l[0], a0l[1], a0l[2], a0l[3], a0h[0], a0h[1], a0h[2], a0h[3]};
            const bf16x8 A1 = (bf16x8){a1l[0], a1l[1], a1l[2], a1l[3], a1h[0], a1h[1], a1h[2], a1h[3]};
            o0 = __builtin_amdgcn_mfma_f32_32x32x16_bf16(A0, s == 0 ? pb0 : pb1, o0, 0, 0, 0);
            o1 = __builtin_amdgcn_mfma_f32_32x32x16_bf16(A1, s == 0 ? pb0 : pb1, o1, 0, 0, 0);
        }
    }
    l += __shfl_xor(l, 32);
    if (half == 1) { LAS float* x = XC + lane * 34; x[0] = m; x[1] = l;
#pragma unroll
        for (int r = 0; r < 16; ++r) { x[2 + r] = o0[r]; x[18 + r] = o1[r]; } }
    __syncthreads();
    if (half == 0) { const LAS float* x = XC + lane * 34; const float m1 = x[0], l1 = x[1];
        const float M2 = fmaxf(m, m1), w0 = __builtin_amdgcn_exp2f(m - M2), w1 = __builtin_amdgcn_exp2f(m1 - M2), inv = 1.f / (l * w0 + l1 * w1);
        if (r32 < 4) { bf16* gq = ATT + ((size_t)MP + b * 4 + r32) * 512 + h * 64 + 4 * hi;
#pragma unroll
            for (int db = 0; db < 2; ++db)
#pragma unroll
                for (int g4 = 0; g4 < 4; ++g4) { float v[4];
#pragma unroll
                    for (int e = 0; e < 4; ++e) v[e] = ((db == 0 ? o0[4 * g4 + e] : o1[4 * g4 + e]) * w0 + x[2 + 16 * db + 4 * g4 + e] * w1) * inv;
                    pg8::u32x2 w; w.x = cvtpk(v[0], v[1]); w.y = cvtpk(v[2], v[3]); *(pg8::u32x2*)(gq + 32 * db + 8 * g4) = w; } } }
    __syncthreads();
}
}
__device__ __forceinline__ float gelu_tanh(float x) { const float u = 0.7978845608028654f * (x + 0.044715f * x * x * x); return 0.5f * x * (1.0f + tanhf(u)); }

__device__ __forceinline__ void nv_attn_prompt(int w, int lane, const bf16* QB, const bf16* KB, const bf16* VB, bf16* ATT) {
    const int token = w >> 3, h = w & 7, b = token / SEQ, s = token % SEQ;
    const float q = bf2f(QB[(size_t)token * 512 + h * 64 + lane]);
    float m = -1e30f, l = 0.f, o = 0.f;
    for (int c = 0; c < 3; ++c) { const int d = (c == 0) ? 1 : (c == 1 ? 4 : 16);
        for (int mm = 0; mm <= 128; ++mm) { const int pos = s - mm * d; if (pos < 0) break;
            const size_t kt = ((size_t)b * SEQ + pos) * 512 + h * 64 + lane;
            const float sc = wave_sum(q * bf2f(KB[kt]));
            const float mn = fmaxf(m, sc), corr = exp2f(m - mn), p = exp2f(sc - mn);
            l = l * corr + p; o = o * corr + p * bf2f(VB[kt]); m = mn; } }
    ATT[(size_t)token * 512 + h * 64 + lane] = (bf16)f2bf(o / l);
}
__device__ __forceinline__ void nv_attn_sample(int w, int lane, const bf16* QB, const bf16* KB, const bf16* VB, const float* ck, const float* cv, bf16* ATT) {
    const int tok = w >> 3, h = w & 7, b = tok >> 2, t = tok & 3; const size_t row = (size_t)MP + tok;
    const float q = bf2f(QB[row * 512 + h * 64 + lane]);
    float m = -1e30f, l = 0.f, o = 0.f;
    for (int c = 0; c < 3; ++c) { const int d = (c == 0) ? 1 : (c == 1 ? 4 : 16);
        for (int mm = 0; mm <= 128; ++mm) { const int idx = WBUF + t - mm * d; if (idx < 0) break;
            float kv, vv;
            if (idx >= WBUF) { const size_t kr = ((size_t)MP + b * 4 + (idx - WBUF)) * 512 + h * 64 + lane; kv = bf2f(KB[kr]); vv = bf2f(VB[kr]); }
            else { const size_t kr = (((size_t)b * WBUF + idx) * NH + h) * 64 + lane; kv = ck[kr]; vv = cv[kr]; }
            const float sc = wave_sum(q * kv);
            const float mn = fmaxf(m, sc), corr = exp2f(m - mn), p = exp2f(sc - mn);
            l = l * corr + p; o = o * corr + p * vv; m = mn; } }
    ATT[row * 512 + h * 64 + lane] = (bf16)f2bf(o / l);
}
__device__ __forceinline__ void nv_ssm_scan(int gt, const bf16* UB, const float* are, const float* aim, const float* ldt, const float* bre, const float* bim,
                                                    const float* s0r, const float* s0i, float* HF, float* out) {
    const int p = gt & 63, g = (gt >> 6) & 31, sq = gt >> 11;
    const double dt = exp((double)ldt[g]), ar = are[g * NP + p], ai = aim[g * NP + p];
    const double mag = exp(dt * ar), abr_d = mag * cos(dt * ai), abi_d = mag * sin(dt * ai);
    const double den = ar * ar + ai * ai, nr = abr_d - 1.0, ni = abi_d;
    const double cr = (nr * ar + ni * ai) / den, ci = (ni * ar - nr * ai) / den;
    const float abr = (float)abr_d, abi = (float)abi_d;
    float bbr[NCH], bbi[NCH];
#pragma unroll
    for (int c = 0; c < NCH; ++c) { const double br = bre[(g * NP + p) * NCH + c], bi = bim[(g * NP + p) * NCH + c]; bbr[c] = (float)(cr * br - ci * bi); bbi[c] = (float)(cr * bi + ci * br); }
    float hr = 0.f, hi = 0.f; int L, row0;
    if (sq < NB) { L = SEQ; row0 = sq * SEQ; } else { const int b = sq - NB; L = DT; row0 = MP + b * DT; hr = s0r[(b * NG + g) * NP + p]; hi = s0i[(b * NG + g) * NP + p]; }
    float* HR = HF; float* HI = HF + (size_t)M * 2048;
    for (int t = 0; t < L; ++t) {
        const bf16* up = UB + (size_t)(row0 + t) * 512 + g * NCH;
        float sr = 0.f, si = 0.f;
#pragma unroll
        for (int c = 0; c < NCH; ++c) { const float uv = bf2f(up[c]); sr += bbr[c] * uv; si += bbi[c] * uv; }
        const float nhr = abr * hr - abi * hi + sr, nhi = abr * hi + abi * hr + si; hr = nhr; hi = nhi;
        if (HF) { HR[((size_t)(row0 + t) * NG + g) * NP + p] = hr; HI[((size_t)(row0 + t) * NG + g) * NP + p] = hi; }
    }
    if (sq < NB) { out[O_SRP + (sq * NG + g) * NP + p] = hr; out[O_SIP + (sq * NG + g) * NP + p] = hi; }
    else { const int b = sq - NB; out[O_SRS + (b * NG + g) * NP + p] = hr; out[O_SIS + (b * NG + g) * NP + p] = hi; }
}
__device__ __forceinline__ void nv_ssm_out(size_t gt, const bf16* UB, const float* HF, const float* cre, const float* cim, const float* dsk, bf16* GB) {
    const int c = (int)(gt & 511), g = c >> 4, ch = c & 15; const size_t row = gt >> 9;
    const float* HR = HF + (row * NG + g) * NP; const float* HI = HR + (size_t)M * 2048;
    const float* cr = cre + (g * NCH + ch) * NP; const float* ci = cim + (g * NCH + ch) * NP;
    float y = 0.f;
    for (int p = 0; p < NP; ++p) y += cr[p] * HR[p] - ci[p] * HI[p];
    y += dsk[g * NCH + ch] * bf2f(UB[row * 512 + c]);
    GB[row * 512 + c] = (bf16)f2bf(gelu_tanh(y));
}
__device__ __forceinline__ void nv_mixprep(int w, int lane, const bf16* ATT, const bf16* YS, const float* gatt, const float* gssm, bf16* A2) {
    float a[8], y[8]; float sa = 0.f, sy = 0.f;
#pragma unroll
    for (int j = 0; j < 8; ++j) { a[j] = bf2f(ATT[(size_t)w * 512 + j * 64 + lane]); y[j] = bf2f(YS[(size_t)w * 512 + j * 64 + lane]); sa += a[j] * a[j]; sy += y[j] * y[j]; }
    const float ra = rsqrtf(wave_sum(sa) * (1.f / 512.f) + LN_EPS), ry = rsqrtf(wave_sum(sy) * (1.f / 512.f) + LN_EPS);
#pragma unroll
    for (int j = 0; j < 8; ++j) { A2[(size_t)w * 1024 + j * 64 + lane] = (bf16)f2bf(a[j] * ra * gatt[j * 64 + lane]); A2[(size_t)w * 1024 + 512 + j * 64 + lane] = (bf16)f2bf(y[j] * ry * gssm[j * 64 + lane]); }
}
__device__ __forceinline__ void nv_ln(int w, int lane, const float* PRE, const float* g, const float* b, float* oP, float* oS, bf16* ob) {
    float v[16]; float s = 0.f;
#pragma unroll
    for (int j = 0; j < 16; ++j) { v[j] = PRE[(size_t)w * 1024 + j * 64 + lane]; s += v[j]; }
    const float mean = wave_sum(s) * (1.f / 1024.f); float q = 0.f;
#pragma unroll
    for (int j = 0; j < 16; ++j) { v[j] -= mean; q += v[j] * v[j]; }
    const float rstd = rsqrtf(wave_sum(q) * (1.f / 1024.f) + LN_EPS);
    float* o = (w < MP) ? oP + (size_t)w * 1024 : oS + (size_t)(w - MP) * 1024;
#pragma unroll
    for (int j = 0; j < 16; ++j) { const float r = v[j] * rstd * g[j * 64 + lane] + b[j * 64 + lane]; o[j * 64 + lane] = r; if (ob) ob[(size_t)w * 1024 + j * 64 + lane] = (bf16)f2bf(r); }
}
__device__ __forceinline__ void nv_memattn(int w, int lane, const bf16* QM, const bf16* MKB, const bf16* MVB, const float* cmk, const float* cmv, bf16* OM) {
    const int row = w >> 2, h = w & 3;
    float q[4], o[4] = {0.f, 0.f, 0.f, 0.f};
#pragma unroll
    for (int j = 0; j < 4; ++j) q[j] = bf2f(QM[(size_t)row * 1024 + h * 256 + j * 64 + lane]);
    float m = -1e30f, l = 0.f;
    for (int mm = 0; mm < NMEM; ++mm) {
        float k[4], v[4];
        if (row < MP) { const size_t kr = ((size_t)(row / SEQ) * NMEM + mm) * 1024 + h * 256 + lane;
#pragma unroll
            for (int j = 0; j < 4; ++j) { k[j] = bf2f(MKB[kr + j * 64]); v[j] = bf2f(MVB[kr + j * 64]); } }
        else { const size_t kr = ((size_t)((row - MP) >> 2) * NMEM + mm) * 1024 + h * 256 + lane;
#pragma unroll
            for (int j = 0; j < 4; ++j) { k[j] = cmk[kr + j * 64]; v[j] = cmv[kr + j * 64]; } }
        const float sc = wave_sum(q[0] * k[0] + q[1] * k[1] + q[2] * k[2] + q[3] * k[3]);
        const float mn = fmaxf(m, sc), corr = exp2f(m - mn), p = exp2f(sc - mn);
        l = l * corr + p; m = mn;
#pragma unroll
        for (int j = 0; j < 4; ++j) o[j] = o[j] * corr + p * v[j];
    }
#pragma unroll
    for (int j = 0; j < 4; ++j) OM[(size_t)row * 1024 + h * 256 + j * 64 + lane] = (bf16)f2bf(o[j] / l);
}

namespace ssm {
typedef float f32x4 __attribute__((ext_vector_type(4)));
constexpr int SBU_STR = 80, SBU_BYTES = 128 * SBU_STR, SH_STR = 32, SH_BYTES = 128 * SH_STR, WAVE_BYTES = SBU_BYTES + SH_BYTES;
constexpr int SEGT = 256, NSEG = SEQ / SEGT;
constexpr size_t T_ABAR = 0;
constexpr size_t T_A256 = T_ABAR + 2048 * 2 * 4;
constexpr size_t T_BBT = T_A256 + 2048 * 2 * 4;
constexpr size_t T_CMT = T_BBT + (size_t)32 * 8 * 64 * 8 * 2;
constexpr size_t T_END = T_CMT + (size_t)32 * 4 * 64 * 8 * 2;

__device__ __forceinline__ void make_tables(int gp, const float* are, const float* aim, const float* ldt, const float* bre, const float* bim, const float* cre, const float* cim, unsigned char* tab) {
    const int g = gp >> 6, p = gp & 63;
    const double dt = exp((double)ldt[g]), ar = are[gp], ai = aim[gp];
    const double mag = exp(dt * ar), abr = mag * cos(dt * ai), abi = mag * sin(dt * ai);
    const double den = ar * ar + ai * ai, nr = abr - 1.0, ni = abi;
    const double cr = (nr * ar + ni * ai) / den, ci = (ni * ar - nr * ai) / den;
    float* AB = (float*)(tab + T_ABAR); float* A2 = (float*)(tab + T_A256);
    AB[2 * gp] = (float)abr; AB[2 * gp + 1] = (float)abi;
    const double m256 = exp(256.0 * dt * ar); A2[2 * gp] = (float)(m256 * cos(256.0 * dt * ai)); A2[2 * gp + 1] = (float)(m256 * sin(256.0 * dt * ai));
    bf16* BBT = (bf16*)(tab + T_BBT); bf16* CMT = (bf16*)(tab + T_CMT);
    const int n = p & 15, nt = p >> 4;
    for (int ch = 0; ch < NCH; ++ch) {
        const double br = bre[gp * NCH + ch], bi = bim[gp * NCH + ch];
        const int kg = ch >> 3, j = ch & 7, ln = kg * 16 + n;
        const float vr = (float)(cr * br - ci * bi), vi = (float)(cr * bi + ci * br);
        const bf16 vrh = (bf16)f2bf(vr), vih = (bf16)f2bf(vi);
        BBT[((size_t)(g * 8 + nt) * 64 + ln) * 8 + j] = vrh;
        BBT[((size_t)(g * 8 + 4 + nt) * 64 + ln) * 8 + j] = vih;
        BBT[((size_t)(g * 8 + nt) * 64 + ln + 32) * 8 + j] = (bf16)f2bf(vr - bf2f(vrh));
        BBT[((size_t)(g * 8 + 4 + nt) * 64 + ln + 32) * 8 + j] = (bf16)f2bf(vi - bf2f(vih));
        const int ks = p >> 5, kgc = (p >> 3) & 3, jc = p & 7, lc = kgc * 16 + ch;
        CMT[((size_t)(g * 4 + ks) * 64 + lc) * 8 + jc] = (bf16)f2bf(cre[(g * NCH + ch) * NP + p]);
        CMT[((size_t)(g * 4 + 2 + ks) * 64 + lc) * 8 + jc] = (bf16)f2bf(-cim[(g * NCH + ch) * NP + p]);
    }
}

template <bool FULL>
__device__ __forceinline__ void run(size_t row0, int ntiles, int nvalid, int g, float& hr, float& hi, const bf16* UB, const unsigned char* tab, const float* dsk, bf16* GB, LAS unsigned char* wl, int lane) {
    const int tok = lane & 15, kg = lane >> 4;
    const float abr = ((const float*)(tab + T_ABAR))[2 * (g * 64 + lane)], abi = ((const float*)(tab + T_ABAR))[2 * (g * 64 + lane) + 1];
    bf16x8 bbt[8], cmt[4];
#pragma unroll
    for (int n = 0; n < 8; ++n) bbt[n] = *(const bf16x8*)(tab + T_BBT + ((size_t)(g * 8 + n) * 64 + lane) * 16);
    if (FULL) {
#pragma unroll
        for (int k = 0; k < 4; ++k) cmt[k] = *(const bf16x8*)(tab + T_CMT + ((size_t)(g * 4 + k) * 64 + lane) * 16); }
    f32x4 dv = {0.f, 0.f, 0.f, 0.f};
    if (FULL) dv = *(const f32x4*)(dsk + g * NCH + 4 * kg);
    LAS unsigned char* SBU = wl; LAS unsigned char* SH = wl + SBU_BYTES;
    for (int tile = 0; tile < ntiles; ++tile) {
        size_t row = row0 + 16 * tile + tok; if (row > (size_t)(M - 1)) row = M - 1;
        const bf16x8 uf = *(const bf16x8*)(UB + row * 512 + g * NCH + 8 * (kg & 1));
#pragma unroll
        for (int n = 0; n < 8; ++n) {
            f32x4 acc = {0.f, 0.f, 0.f, 0.f};
            acc = __builtin_amdgcn_mfma_f32_16x16x32_bf16(uf, bbt[n], acc, 0, 0, 0);
            *(LAS f32x4*)(SBU + (n * 16 + tok) * SBU_STR + kg * 16) = acc;
        }
        f32x4 br[4], bi[4];
#pragma unroll
        for (int q = 0; q < 4; ++q) { br[q] = *(const LAS f32x4*)(SBU + lane * SBU_STR + q * 16); bi[q] = *(const LAS f32x4*)(SBU + (64 + lane) * SBU_STR + q * 16); }
        float sr[16], si[16];
#pragma unroll
        for (int t = 0; t < 16; ++t) {
            const float nhr = abr * hr - abi * hi + br[t >> 2][t & 3], nhi = abr * hi + abi * hr + bi[t >> 2][t & 3];
            sr[t] = nhr; si[t] = nhi;
            if (t < nvalid) { hr = nhr; hi = nhi; }
        }
        if (FULL) {
            pg8::u32x4 w0, w1, w2, w3;
            w0.x = att::cvtpk(sr[0], sr[1]); w0.y = att::cvtpk(sr[2], sr[3]); w0.z = att::cvtpk(sr[4], sr[5]); w0.w = att::cvtpk(sr[6], sr[7]);
            w1.x = att::cvtpk(sr[8], sr[9]); w1.y = att::cvtpk(sr[10], sr[11]); w1.z = att::cvtpk(sr[12], sr[13]); w1.w = att::cvtpk(sr[14], sr[15]);
            w2.x = att::cvtpk(si[0], si[1]); w2.y = att::cvtpk(si[2], si[3]); w2.z = att::cvtpk(si[4], si[5]); w2.w = att::cvtpk(si[6], si[7]);
            w3.x = att::cvtpk(si[8], si[9]); w3.y = att::cvtpk(si[10], si[11]); w3.z = att::cvtpk(si[12], si[13]); w3.w = att::cvtpk(si[14], si[15]);
            *(LAS pg8::u32x4*)(SH + lane * SH_STR) = w0; *(LAS pg8::u32x4*)(SH + lane * SH_STR + 16) = w1;
            *(LAS pg8::u32x4*)(SH + (64 + lane) * SH_STR) = w2; *(LAS pg8::u32x4*)(SH + (64 + lane) * SH_STR + 16) = w3;
            f32x4 y = {0.f, 0.f, 0.f, 0.f};
            const LAS unsigned char* trb = SH + (8 * kg + (tok >> 2)) * SH_STR + (tok & 3) * 8;
#pragma unroll
            for (int ks = 0; ks < 4; ++ks) {
                const att::s16x4 lo = att::vtr(trb + (32 * ks) * SH_STR), hi4 = att::vtr(trb + (32 * ks + 4) * SH_STR);
                const bf16x8 hf = (bf16x8){lo[0], lo[1], lo[2], lo[3], hi4[0], hi4[1], hi4[2], hi4[3]};
                y = __builtin_amdgcn_mfma_f32_16x16x32_bf16(cmt[ks], hf, y, 0, 0, 0);
            }
            const pg8::u32x2 uw = *(const pg8::u32x2*)(UB + row * 512 + g * NCH + 4 * kg);
            const float y0 = y[0] + dv[0] * pg8::bf_lo(uw.x), y1 = y[1] + dv[1] * pg8::bf_hi(uw.x), y2 = y[2] + dv[2] * pg8::bf_lo(uw.y), y3 = y[3] + dv[3] * pg8::bf_hi(uw.y);
            pg8::u32x2 gw; gw.x = att::cvtpk(gelu_tanh(y0), gelu_tanh(y1)); gw.y = att::cvtpk(gelu_tanh(y2), gelu_tanh(y3));
            if (tok < nvalid) *(pg8::u32x2*)(GB + (row0 + 16 * tile + tok) * 512 + g * NCH + 4 * kg) = gw;
        }
    }
}
}
namespace sk {
typedef float f32x4 __attribute__((ext_vector_type(4)));
template <int CT, class Epi>
__device__ __forceinline__ void gemm(const bf16* A, int lda, const bf16* Bt, int K, int ncb, int unit, LAS unsigned char* lds, int wave, int lane, const Epi& E) {
    const int rb = unit & 7, cb = unit >> 3, r16 = lane & 15, kq = lane >> 4;
    const int ksteps = K >> 8, k0 = wave * (K >> 3);
    const bf16* ap = A + (size_t)(rb * 64 + r16) * lda + k0 + 8 * kq;
    LAS f32x4* red = (LAS f32x4*)lds;
    for (int c0 = 0; c0 < ncb; c0 += 16 * CT) {
        const int nct = (ncb - c0) / 16 < CT ? (ncb - c0) / 16 : CT;
        const bf16* bp = Bt + (size_t)(cb * ncb + c0 + r16) * K + k0 + 8 * kq;
        f32x4 acc[4][CT];
#pragma unroll
        for (int r = 0; r < 4; ++r)
#pragma unroll
            for (int c = 0; c < CT; ++c) acc[r][c] = (f32x4){0.f, 0.f, 0.f, 0.f};
#pragma unroll 2
        for (int ks = 0; ks < ksteps; ++ks) {
            bf16x8 a[4], b[CT];
#pragma unroll
            for (int r = 0; r < 4; ++r) a[r] = *(const bf16x8*)(ap + (size_t)r * 16 * lda + ks * 32);
#pragma unroll
            for (int c = 0; c < CT; ++c) b[c] = (c < nct) ? *(const bf16x8*)(bp + (size_t)c * 16 * K + ks * 32) : (bf16x8){0, 0, 0, 0, 0, 0, 0, 0};
#pragma unroll
            for (int r = 0; r < 4; ++r)
#pragma unroll
                for (int c = 0; c < CT; ++c) acc[r][c] = __builtin_amdgcn_mfma_f32_16x16x32_bf16(b[c], a[r], acc[r][c], 0, 0, 0);
        }
#pragma unroll
        for (int r = 0; r < 4; ++r)
#pragma unroll
            for (int c = 0; c < CT; ++c) red[(wave * 4 * CT + r * CT + c) * 64 + lane] = acc[r][c];
        __syncthreads();
        for (int t = wave; t < 4 * CT; t += 8) {
            const int r = t / CT, c = t % CT;
            if (c < nct) {
                f32x4 s = red[t * 64 + lane];
#pragma unroll
                for (int w = 1; w < 8; ++w) s += red[(w * 4 * CT + t) * 64 + lane];
                E(s, rb * 64 + r * 16 + r16, cb * ncb + c0 + c * 16 + 4 * kq, lane);
            }
        }
        __syncthreads();
    }
}
struct EIn { bf16 *Q, *Kb, *Vb, *U; float *wks, *wvs;
    __device__ __forceinline__ void operator()(f32x4 v, int row, int col, int) const {
        const int t = col >> 9, cc = col & 511; const size_t o = (size_t)(MP + row) * 512 + cc;
        bf16* base = t == 0 ? Q : (t == 1 ? Kb : (t == 2 ? Vb : U));
        if (t == 0) v = v * QSCALE;
        pg8::u32x2 w; w.x = att::cvtpk(v[0], v[1]); w.y = att::cvtpk(v[2], v[3]); *(pg8::u32x2*)(base + o) = w;
        if (t == 1) *(f32x4*)(wks + (size_t)row * 512 + cc) = v;
        if (t == 2) *(f32x4*)(wvs + (size_t)row * 512 + cc) = v; } };
struct EGlu { const bf16* Gb; const float* bias; bf16* O;
    __device__ __forceinline__ void operator()(f32x4 v, int row, int col, int) const {
        const size_t o = (size_t)(MP + row) * 512 + col; const pg8::u32x2 gw = *(const pg8::u32x2*)(Gb + o); const f32x4 b = *(const f32x4*)(bias + col);
        pg8::u32x2 w; w.x = att::cvtpk(pg8::bf_lo(gw.x) * pg8::sigmoidf_(v[0] + b[0]), pg8::bf_hi(gw.x) * pg8::sigmoidf_(v[1] + b[1]));
        w.y = att::cvtpk(pg8::bf_lo(gw.y) * pg8::sigmoidf_(v[2] + b[2]), pg8::bf_hi(gw.y) * pg8::sigmoidf_(v[3] + b[3])); *(pg8::u32x2*)(O + o) = w; } };
struct ERes { const float* res; float* out; float alpha;
    __device__ __forceinline__ void operator()(f32x4 v, int row, int col, int) const {
        const f32x4 r = *(const f32x4*)(res + (size_t)row * 1024 + col); *(f32x4*)(out + (size_t)(MP + row) * 1024 + col) = r * alpha + v; } };
struct EBf { bf16* O; float scale;
    __device__ __forceinline__ void operator()(f32x4 v, int row, int col, int) const {
        v = v * scale; pg8::u32x2 w; w.x = att::cvtpk(v[0], v[1]); w.y = att::cvtpk(v[2], v[3]); *(pg8::u32x2*)(O + (size_t)(MP + row) * 1024 + col) = w; } };
struct EGateUp { bf16* H;
    __device__ __forceinline__ void operator()(f32x4 v, int row, int col, int lane) const {
        f32x4 p; p[0] = __shfl_xor(v[0], 16); p[1] = __shfl_xor(v[1], 16); p[2] = __shfl_xor(v[2], 16); p[3] = __shfl_xor(v[3], 16);
        if (((lane >> 4) & 1) == 0) {
            pg8::u32x2 w; w.x = att::cvtpk(v[0] * pg8::sigmoidf_(v[0]) * p[0], v[1] * pg8::sigmoidf_(v[1]) * p[1]); w.y = att::cvtpk(v[2] * pg8::sigmoidf_(v[2]) * p[2], v[3] * pg8::sigmoidf_(v[3]) * p[3]);
            *(pg8::u32x2*)(H + (size_t)(MP + row) * DFF + (col >> 1)) = w; } } };
}
namespace matt {
typedef float f32x4 __attribute__((ext_vector_type(4)));
constexpr int VS = 528, VT_BYTES = 16 * VS;
constexpr int XC_OFF = 8 * VT_BYTES;
__device__ __forceinline__ void sample_unit(int b, int hp, const bf16* QM, const float* cmk, const float* cmv, bf16* OM, LAS unsigned char* lds, int wave, int lane) {
    const int c16 = lane & 15, kq = lane >> 4, h = 2 * hp + (wave & 1), mq = wave >> 1, t = c16 & 3;
    LAS unsigned char* vt = lds + wave * VT_BYTES;
    LAS float* XC = (LAS float*)(lds + XC_OFF);
    bf16x8 qf[8];
    { const bf16* qp = QM + ((size_t)MP + b * 4 + t) * 1024 + h * 256 + 8 * kq;
#pragma unroll
      for (int ks = 0; ks < 8; ++ks) qf[ks] = *(const bf16x8*)(qp + 32 * ks); }
    float m = -1e30f, l = 0.f; f32x4 o[16];
#pragma unroll
    for (int i = 0; i < 16; ++i) o[i] = (f32x4){0.f, 0.f, 0.f, 0.f};
    const LAS unsigned char* trb = vt + (4 * kq + (c16 >> 2)) * VS + (c16 & 3) * 8;
    for (int st = 0; st < 4; ++st) {
        const int key0 = 64 * mq + 16 * st;
        const float* kp = cmk + (((size_t)b * NMEM + key0 + c16) * 4 + h) * 256 + 8 * kq;
        f32x4 s4 = {0.f, 0.f, 0.f, 0.f};
#pragma unroll
        for (int kh = 0; kh < 2; ++kh) {
            f32x4 ka[4][2];
#pragma unroll
            for (int ks = 0; ks < 4; ++ks) { ka[ks][0] = *(const f32x4*)(kp + 32 * (4 * kh + ks)); ka[ks][1] = *(const f32x4*)(kp + 32 * (4 * kh + ks) + 4); }
#pragma unroll
            for (int ks = 0; ks < 4; ++ks) { pg8::u32x4 w; w.x = att::cvtpk(ka[ks][0][0], ka[ks][0][1]); w.y = att::cvtpk(ka[ks][0][2], ka[ks][0][3]); w.z = att::cvtpk(ka[ks][1][0], ka[ks][1][1]); w.w = att::cvtpk(ka[ks][1][2], ka[ks][1][3]);
                s4 = __builtin_amdgcn_mfma_f32_16x16x32_bf16(__builtin_bit_cast(bf16x8, w), qf[4 * kh + ks], s4, 0, 0, 0); }
            asm volatile("" ::: "memory");
        }
        asm volatile("" ::: "memory");
#pragma unroll
        for (int vh = 0; vh < 2; ++vh) {
            f32x4 va[8];
#pragma unroll
            for (int i = 0; i < 8; ++i) va[i] = *(const f32x4*)(cmv + (((size_t)b * NMEM + key0 + 8 * vh + i) * 4 + h) * 256 + 4 * lane);
#pragma unroll
            for (int i = 0; i < 8; ++i) { pg8::u32x2 w; w.x = att::cvtpk(va[i][0], va[i][1]); w.y = att::cvtpk(va[i][2], va[i][3]); *(LAS pg8::u32x2*)(vt + (8 * vh + i) * VS + lane * 8) = w; }
            asm volatile("" ::: "memory");
        }
        float mx = fmaxf(fmaxf(s4[0], s4[1]), fmaxf(s4[2], s4[3]));
        mx = fmaxf(mx, __shfl_xor(mx, 16)); mx = fmaxf(mx, __shfl_xor(mx, 32));
        const float mn = fmaxf(m, mx), corr = __builtin_amdgcn_exp2f(m - mn); m = mn;
        const float p0 = __builtin_amdgcn_exp2f(s4[0] - mn), p1 = __builtin_amdgcn_exp2f(s4[1] - mn), p2 = __builtin_amdgcn_exp2f(s4[2] - mn), p3 = __builtin_amdgcn_exp2f(s4[3] - mn);
        l = l * corr + ((p0 + p1) + (p2 + p3));
        pg8::u32x4 pw; pw.x = att::cvtpk(p0, p1); pw.y = att::cvtpk(p2, p3); pw.z = 0u; pw.w = 0u;
        const bf16x8 pb = __builtin_bit_cast(bf16x8, pw);
#pragma unroll
        for (int dt = 0; dt < 16; ++dt) {
            const att::s16x4 lo = att::vtr(trb + dt * 32);
            const bf16x8 A = (bf16x8){lo[0], lo[1], lo[2], lo[3], lo[0], lo[1], lo[2], lo[3]};
            o[dt] = o[dt] * corr;
            o[dt] = __builtin_amdgcn_mfma_f32_16x16x32_bf16(A, pb, o[dt], 0, 0, 0);
        }
    }
    l += __shfl_xor(l, 16); l += __shfl_xor(l, 32);
    if (c16 < 4) { LAS float* x = XC + (wave * 4 + c16) * 258;
        if (kq == 0) { x[256] = m; x[257] = l; }
#pragma unroll
        for (int dt = 0; dt < 16; ++dt) *(LAS f32x4*)(x + 16 * dt + 4 * kq) = o[dt]; }
    __syncthreads();
    if (mq == 0 && c16 < 4) {
        float mm[4], ll[4], M2 = -1e30f;
#pragma unroll
        for (int q4 = 0; q4 < 4; ++q4) { const LAS float* x = XC + ((2 * q4 + (wave & 1)) * 4 + c16) * 258; mm[q4] = x[256]; ll[q4] = x[257]; M2 = fmaxf(M2, mm[q4]); }
        float den = 0.f, wq[4];
#pragma unroll
        for (int q4 = 0; q4 < 4; ++q4) { wq[q4] = __builtin_amdgcn_exp2f(mm[q4] - M2); den += ll[q4] * wq[q4]; }
        const float inv = 1.f / den;
        bf16* op = OM + ((size_t)MP + b * 4 + c16) * 1024 + h * 256 + 4 * kq;
#pragma unroll
        for (int dt = 0; dt < 16; ++dt) { f32x4 acc = {0.f, 0.f, 0.f, 0.f};
#pragma unroll
            for (int q4 = 0; q4 < 4; ++q4) { const f32x4 v = *(const LAS f32x4*)(XC + ((2 * q4 + (wave & 1)) * 4 + c16) * 258 + 16 * dt + 4 * kq); acc += v * wq[q4]; }
            acc = acc * inv; pg8::u32x2 w; w.x = att::cvtpk(acc[0], acc[1]); w.y = att::cvtpk(acc[2], acc[3]); *(pg8::u32x2*)(op + 16 * dt) = w; }
    }
    __syncthreads();
}
}
__global__ void __launch_bounds__(NWAVES * 64, 2) skel_fwd(Args args) {
    extern __shared__ __attribute__((aligned(16))) unsigned char lds[];
    LAS unsigned char* L = (LAS unsigned char*)lds;
    volatile LAS unsigned* MISC = (volatile LAS unsigned*)(L + MISC_OFF);
    const int tid = threadIdx.x, lane = tid & 63, wave = __builtin_amdgcn_readfirstlane(tid >> 6);
    const int G = gridDim.x; const int bx = blockIdx.x; const int vcu = (G % 8 == 0) ? (bx % 8) * (G / 8) + bx / 8 : bx;
    unsigned char* ws = args.ws;
    gu32* ctl = (gu32*)(ws + WS_CTL);
    for (int u = tid; u < (LDS_BYTES - LDSCTL_OFF) / 4; u += NWAVES * 64) ((LAS unsigned*)(L + LDSCTL_OFF))[u] = 0u;
    __syncthreads();
    XcdBarrier bar = xcd_barrier_post((unsigned*)(ctl + CW_BAR) + args.li * XCD_BAR_WORDS, MISC + 8);
#define GRID_BAR() xcd_barrier(bar)
    const int lo = args.ph_lo, hi = args.ph_hi; const int NGW = G * NWAVES;
#define IN(k) (lo <= (k) && (k) < hi)
#define PH_LOCALS int tid_ = threadIdx.x; asm volatile("" : "+v"(tid_)); const int tid = tid_, lane = tid_ & 63, wave = __builtin_amdgcn_readfirstlane(tid_ >> 6), gw = vcu * NWAVES + wave; (void)tid; (void)lane; (void)wave; (void)gw
#define BOTH(k) (IN(k) && IN((k) + 1))
    bf16* WIN_t = (bf16*)(ws + WS_WIN); bf16* WGLU_t = (bf16*)(ws + WS_WGLU); bf16* WOUT_t = (bf16*)(ws + WS_WOUT); bf16* WMQ_t = (bf16*)(ws + WS_WMQ);
    bf16* WMKV_t = (bf16*)(ws + WS_WMKV); bf16* WMO_t = (bf16*)(ws + WS_WMO); bf16* WGU_t = (bf16*)(ws + WS_WGU); bf16* WDN_t = (bf16*)(ws + WS_WDN);
    bf16* XB = (bf16*)(ws + WS_XB); bf16* MPB = (bf16*)(ws + WS_MPB);
    bf16* QB = (bf16*)(ws + WS_QB); bf16* KB = (bf16*)(ws + WS_KB); bf16* VB = (bf16*)(ws + WS_VB); bf16* UB = (bf16*)(ws + WS_UB);
    bf16* MKB = (bf16*)(ws + WS_MKB); bf16* MVB = (bf16*)(ws + WS_MVB); bf16* MVT = (bf16*)(ws + WS_MVT); bf16* PB = (bf16*)(ws + WS_PB);
    bf16* GB = (bf16*)(ws + WS_GB); bf16* YS = (bf16*)(ws + WS_YS); bf16* A2 = (bf16*)(ws + WS_A2);
    float* PRE = (float*)(ws + WS_PRE); float* X1 = (float*)(ws + WS_X1); bf16* X1B = (bf16*)(ws + WS_X1B); float* X2 = (float*)(ws + WS_X2); bf16* X2B = (bf16*)(ws + WS_X2B);
    bf16* QM = (bf16*)(ws + WS_QM); bf16* OM = (bf16*)(ws + WS_OM); bf16* HB = (bf16*)(ws + WS_H);
    float* out = args.out;

    if (IN(PH_PRO)) { PH_LOCALS;
        LAS float* scr = (LAS float*)(L + RING_OFF + wave * 16384);
        constexpr int I_IN = (DM / 64) * (DIN / 32), I_GLU = (DSSM / 64) * (DSSM / 32), I_SQ = (DM / 64) * (DM / 32), I_FF = (DM / 64) * (DFF / 32), I_DN = (DFF / 64) * (DM / 32);
        constexpr int NITEMS = I_IN + I_GLU + 5 * I_SQ + 2 * I_FF + I_DN;
        for (int it = gw; it < NITEMS; it += NGW) {
            int r = it;
            if (r < I_IN) { p0_transpose_item<0>(args.in[I_WIN], DM, DIN, WIN_t, 0, scr, r, lane); continue; } r -= I_IN;
            if (r < I_GLU) { p0_transpose_item<0>(args.in[I_WGLU], DSSM, DSSM, WGLU_t, 0, scr, r, lane); continue; } r -= I_GLU;
            if (r < I_SQ) { p0_transpose_item<0>(args.in[I_WOUT], DM, DM, WOUT_t, 0, scr, r, lane); continue; } r -= I_SQ;
            if (r < I_SQ) { p0_transpose_item<0>(args.in[I_WMQ], DM, DM, WMQ_t, 0, scr, r, lane); continue; } r -= I_SQ;
            if (r < I_SQ) { p0_transpose_item<0>(args.in[I_WMK], DM, DM, WMKV_t, 0, scr, r, lane); continue; } r -= I_SQ;
            if (r < I_SQ) { p0_transpose_item<0>(args.in[I_WMV], DM, DM, WMKV_t, DM, scr, r, lane); continue; } r -= I_SQ;
            if (r < I_SQ) { p0_transpose_item<0>(args.in[I_WMO], DM, DM, WMO_t, 0, scr, r, lane); continue; } r -= I_SQ;
            if (r < I_FF) { p0_transpose_item<1>(args.in[I_WGATE], DM, DFF, WGU_t, 0, scr, r, lane); continue; } r -= I_FF;
            if (r < I_FF) { p0_transpose_item<1>(args.in[I_WUP], DM, DFF, WGU_t, 4, scr, r, lane); continue; } r -= I_FF;
            p0_transpose_item<0>(args.in[I_WDOWN], DFF, DM, WDN_t, 0, scr, r, lane);
        }
        const size_t gt = (size_t)vcu * (NWAVES * 64) + tid, ngt = (size_t)G * NWAVES * 64;
        p0_convert(args.in[I_XP], XB, (size_t)MP * DM / 8, gt, ngt);
        p0_convert(args.in[I_XS], XB + (size_t)MP * DM, (size_t)MS * DM / 8, gt, ngt);
        p0_convert(args.in[I_MEMP], MPB, (size_t)MM * DM / 8, gt, ngt);
        for (int i = (int)gt; i < NG * NP; i += (int)ngt) ssm::make_tables(i, args.in[I_ARE], args.in[I_AIM], args.in[I_LDT], args.in[I_BRE], args.in[I_BIM], args.in[I_CRE], args.in[I_CIM], ws + WS_STAB);
        if (BOTH(PH_PRO)) GRID_BAR();
    }
    if (IN(PH_IN)) { PH_LOCALS;
        { pg8::Gemm g{XB, WIN_t, MP, DIN, DM}; pg8::StaticOrder S; S.init(MP, DIN, G, bx);
          pg8::EpiIn E{QB, KB, VB, UB, out + O_WKP, out + O_WVP, out + O_WKS, out + O_WVS, QSCALE, MP};
          pg8::gemm_phase<pg8::EpiIn, pg8::StaticOrder, true, true>(L + RING_OFF, g, S, E); }
        { pg8::Gemm g{MPB, WMKV_t, MM, 2 * DM, DM}; pg8::StaticOrder S; S.init(MM, 2 * DM, G, bx);
          pg8::EpiMkv E{out + O_MKP, out + O_MVP, MKB, MVB};
          pg8::gemm_phase<pg8::EpiMkv, pg8::StaticOrder, true, true>(L + RING_OFF, g, S, E); }
        { pg8::Gemm g{WMKV_t + (size_t)DM * DM, MPB, DM, MM, DM}; pg8::StaticOrder S; S.init(DM, MM, G, bx);
          pg8::EpiBfS E{MVT, MM, 1.0f};
          pg8::gemm_phase<pg8::EpiBfS, pg8::StaticOrder, true, true>(L + RING_OFF, g, S, E); }
        { sk::EIn E{QB, KB, VB, UB, out + O_WKS, out + O_WVS}; for (int u = vcu; u < 256; u += G) sk::gemm<4>(XB + (size_t)MP * DM, DM, WIN_t, DM, DIN / 32, u, L + RING_OFF, wave, lane, E); }
        if (BOTH(PH_IN)) GRID_BAR();
    }
    bf16* ATT = (bf16*)(ws + WS_ATT); float* SEG = (float*)(ws + WS_SEG); typedef float f32x2 __attribute__((ext_vector_type(2)));
    if (IN(PH_ATT)) { PH_LOCALS;
        for (int u = vcu; u < 256; u += G) att::attn_prompt_unit(u >> 5, (u >> 2) & 7, u & 3, QB, KB, VB, ATT, L + RING_OFF, wave, lane);
        for (int u = vcu; u < 256; u += G) att::attn_sample_unit(u >> 1, u & 1, QB, KB, VB, args.in[I_CWK], args.in[I_CWV], ATT, L + RING_OFF, wave, lane);
        for (int u = vcu; u < 256; u += G) {
            const int b = u >> 5, sgm = (u >> 2) & 7, g = (u & 3) * 8 + wave; float hr = 0.f, hi = 0.f;
            ssm::run<false>((size_t)b * SEQ + sgm * ssm::SEGT, ssm::SEGT / 16, 16, g, hr, hi, UB, ws + WS_STAB, args.in[I_DSK], GB, L + RING_OFF + wave * ssm::WAVE_BYTES, lane);
            f32x2 sv = {hr, hi}; *(f32x2*)(SEG + ((size_t)((b * 8 + sgm) * NG + g) * NP + lane) * 2) = sv;
        }
        if (BOTH(PH_ATT)) GRID_BAR();
    }
    if (IN(PH_SSM)) { PH_LOCALS;
        for (int u = vcu; u < 256; u += G) {
            const int b = u >> 5, sgm = (u >> 2) & 7, g = (u & 3) * 8 + wave; float hr = 0.f, hi = 0.f;
            const float a2r = ((const float*)(ws + WS_STAB + ssm::T_A256))[2 * (g * NP + lane)], a2i = ((const float*)(ws + WS_STAB + ssm::T_A256))[2 * (g * NP + lane) + 1];
            for (int s = 0; s < sgm; ++s) { const f32x2 sv = *(const f32x2*)(SEG + ((size_t)((b * 8 + s) * NG + g) * NP + lane) * 2);
                const float nr = a2r * hr - a2i * hi + sv.x, ni = a2r * hi + a2i * hr + sv.y; hr = nr; hi = ni; }
            ssm::run<true>((size_t)b * SEQ + sgm * ssm::SEGT, ssm::SEGT / 16, 16, g, hr, hi, UB, ws + WS_STAB, args.in[I_DSK], GB, L + RING_OFF + wave * ssm::WAVE_BYTES, lane);
            if (sgm == ssm::NSEG - 1) { out[O_SRP + (b * NG + g) * NP + lane] = hr; out[O_SIP + (b * NG + g) * NP + lane] = hi; }
        }
        for (int w = gw; w < DB * NG; w += NGW) {
            const int b = w >> 5, g = w & 31; float hr = args.in[I_SRE][(b * NG + g) * NP + lane], hi = args.in[I_SIM][(b * NG + g) * NP + lane];
            ssm::run<true>((size_t)MP + b * DT, 1, DT, g, hr, hi, UB, ws + WS_STAB, args.in[I_DSK], GB, L + RING_OFF + wave * ssm::WAVE_BYTES, lane);
            out[O_SRS + (b * NG + g) * NP + lane] = hr; out[O_SIS + (b * NG + g) * NP + lane] = hi;
        }
        if (BOTH(PH_SSM)) GRID_BAR();
    }
    if (IN(PH_GLU)) { PH_LOCALS;
        pg8::Gemm g{GB, WGLU_t, MP, DSSM, DSSM}; pg8::StaticOrder S; S.init(MP, DSSM, G, bx);
        pg8::EpiGlu E{GB, args.in[I_BGLU], YS};
        pg8::gemm_phase<pg8::EpiGlu, pg8::StaticOrder, true, true>(L + RING_OFF, g, S, E);
        { sk::EGlu E{GB, args.in[I_BGLU], YS}; for (int u = vcu; u < 256; u += G) sk::gemm<1>(GB + (size_t)MP * 512, 512, WGLU_t, DSSM, DSSM / 32, u, L + RING_OFF, wave, lane, E); }
        if (BOTH(PH_GLU)) GRID_BAR();
    }
    if (IN(PH_MIX)) { PH_LOCALS;
        for (int w = gw; w < M; w += NGW) nv_mixprep(w, lane, ATT, YS, args.in[I_GATT], args.in[I_GSSM], A2);
        if (BOTH(PH_MIX)) GRID_BAR();
    }
    if (IN(PH_WOUT)) { PH_LOCALS;
        pg8::Gemm g{A2, WOUT_t, MP, DM, DM}; pg8::StaticOrder S; S.init(MP, DM, G, bx);
        pg8::EpiRes E{args.in[I_XP], args.in[I_XS], PRE, ALPHA, MP};
        pg8::gemm_phase<pg8::EpiRes, pg8::StaticOrder, true, true>(L + RING_OFF, g, S, E);
        { sk::ERes E{args.in[I_XS], PRE, ALPHA}; for (int u = vcu; u < 256; u += G) sk::gemm<2>(A2 + (size_t)MP * DM, DM, WOUT_t, DM, DM / 32, u, L + RING_OFF, wave, lane, E); }
        if (BOTH(PH_WOUT)) GRID_BAR();
    }
    if (IN(PH_LN1)) { PH_LOCALS;
        for (int w = gw; w < M; w += NGW) nv_ln(w, lane, PRE, args.in[I_LN1G], args.in[I_LN1B], X1, X1 + (size_t)MP * DM, X1B);
        if (BOTH(PH_LN1)) GRID_BAR();
    }
    if (IN(PH_MQ)) { PH_LOCALS;
        pg8::Gemm g{X1B, WMQ_t, MP, DM, DM}; pg8::StaticOrder S; S.init(MP, DM, G, bx);
        pg8::EpiBfS E{QM, DM, MQSCALE};
        pg8::gemm_phase<pg8::EpiBfS, pg8::StaticOrder, true, true>(L + RING_OFF, g, S, E);
        { sk::EBf E{QM, MQSCALE}; for (int u = vcu; u < 256; u += G) sk::gemm<2>(X1B + (size_t)MP * DM, DM, WMQ_t, DM, DM / 32, u, L + RING_OFF, wave, lane, E); }
        if (BOTH(PH_MQ)) GRID_BAR();
    }
    if (IN(PH_MA1)) { PH_LOCALS;
        { pg8::Gemm g{QM, MKB, MP, NMEM, 256, DM, DM}; pg8::MemOrder<0> S{G, vcu};
          pg8::EpiSoftmax E{PB, DM};
          pg8::gemm_phase<pg8::EpiSoftmax, pg8::MemOrder<0>, false, true>(L + RING_OFF, g, S, E); }
        __syncthreads();
        for (int u = vcu; u < 256; u += G) matt::sample_unit(u >> 1, u & 1, QM, args.in[I_CMK], args.in[I_CMV], OM, L + RING_OFF, wave, lane);
        if (BOTH(PH_MA1)) GRID_BAR();
    }
    if (IN(PH_MA2)) { PH_LOCALS;
        pg8::Gemm g{PB, MVT, MP, 256, NMEM, DM, MM}; pg8::MemOrder<1> S{G, vcu};
        pg8::EpiBfS E{OM, DM, 1.0f};
        pg8::gemm_phase<pg8::EpiBfS, pg8::MemOrder<1>, false, true>(L + RING_OFF, g, S, E);
        if (BOTH(PH_MA2)) GRID_BAR();
    }
    if (IN(PH_MO)) { PH_LOCALS;
        pg8::Gemm g{OM, WMO_t, MP, DM, DM}; pg8::StaticOrder S; S.init(MP, DM, G, bx);
        pg8::EpiRes E{X1, X1 + (size_t)MP * DM, PRE, ALPHA, MP};
        pg8::gemm_phase<pg8::EpiRes, pg8::StaticOrder, true, true>(L + RING_OFF, g, S, E);
        { sk::ERes E{X1 + (size_t)MP * DM, PRE, ALPHA}; for (int u = vcu; u < 256; u += G) sk::gemm<2>(OM + (size_t)MP * DM, DM, WMO_t, DM, DM / 32, u, L + RING_OFF, wave, lane, E); }
        if (BOTH(PH_MO)) GRID_BAR();
    }
    if (IN(PH_LN2)) { PH_LOCALS;
        for (int w = gw; w < M; w += NGW) nv_ln(w, lane, PRE, args.in[I_LN2G], args.in[I_LN2B], X2, X2 + (size_t)MP * DM, X2B);
        if (BOTH(PH_LN2)) GRID_BAR();
    }
    if (IN(PH_GU)) { PH_LOCALS;
        pg8::Gemm g{X2B, WGU_t, MP, 2 * DFF, DM}; pg8::StaticOrder S; S.init(MP, 2 * DFF, G, bx);
        pg8::EpiGateUp E{HB, DFF};
        pg8::gemm_phase<pg8::EpiGateUp, pg8::StaticOrder, true, true>(L + RING_OFF, g, S, E);
        { sk::EGateUp E{HB}; for (int u = vcu; u < 256; u += G) sk::gemm<4>(X2B + (size_t)MP * DM, DM, WGU_t, DM, 2 * DFF / 32, u, L + RING_OFF, wave, lane, E); }
        if (BOTH(PH_GU)) GRID_BAR();
    }
    if (IN(PH_DN)) { PH_LOCALS;
        pg8::Gemm g{HB, WDN_t, MP, DM, DFF}; pg8::StaticOrder S; S.init(MP, DM, G, bx);
        pg8::EpiRes E{X2, X2 + (size_t)MP * DM, PRE, ALPHA, MP};
        pg8::gemm_phase<pg8::EpiRes, pg8::StaticOrder, true, true>(L + RING_OFF, g, S, E);
        { sk::ERes E{X2 + (size_t)MP * DM, PRE, ALPHA}; for (int u = vcu; u < 256; u += G) sk::gemm<2>(HB + (size_t)MP * DFF, DFF, WDN_t, DFF, DM / 32, u, L + RING_OFF, wave, lane, E); }
        if (BOTH(PH_DN)) GRID_BAR();
    }
    if (IN(PH_LN3)) { PH_LOCALS;
        for (int w = gw; w < M; w += NGW) nv_ln(w, lane, PRE, args.in[I_LN3G], args.in[I_LN3B], out + O_YP, out + O_YS, nullptr);
    }
#undef IN
#undef BOTH
}

extern "C" void kernel_launch(void* const* d_in, const int* in_sizes, int n_in, void* d_out, int out_size, void* d_ws, size_t ws_size, hipStream_t stream) {
    static int grid = 0;
    if (grid == 0) {
        if (n_in != N_IN || in_sizes[0] != MP * DM || out_size != (int)O_END || ws_size < WS_END) {
            fprintf(stderr, "kernel_launch: shape mismatch: n_in %d in0 %d out %d ws %zu (need %zu); nothing launched\n", n_in, n_in > 0 ? in_sizes[0] : -1, out_size, ws_size, (size_t)WS_END); grid = -1; return; }
        int dev = 0, cus = 0, per_cu = 0;
        if (hipGetDevice(&dev) != hipSuccess || hipDeviceGetAttribute(&cus, hipDeviceAttributeMultiprocessorCount, dev) != hipSuccess) { grid = -1; return; }
        if (hipFuncSetAttribute((const void*)skel_fwd, hipFuncAttributeMaxDynamicSharedMemorySize, LDS_BYTES) != hipSuccess) { fprintf(stderr, "kernel_launch: hipFuncSetAttribute failed\n"); grid = -1; return; }
        if (hipOccupancyMaxActiveBlocksPerMultiprocessor(&per_cu, (const void*)skel_fwd, NWAVES * 64, LDS_BYTES) != hipSuccess || per_cu < 1)
            fprintf(stderr, "kernel_launch: note: occupancy query reports %d workgroups per CU\n", per_cu);
        (void)hipGetLastError();
        grid = cus;
    }
    if (grid < 0) return;
    (void)hipMemsetAsync((char*)d_ws + WS_CTL, 0, CTL_ZERO_BYTES, stream);
    Args a{};
    for (int i = 0; i < N_IN; ++i) a.in[i] = (const float*)d_in[i];
    a.out = (float*)d_out; a.ws = (unsigned char*)d_ws;
#ifdef REP_LO
    a.ph_lo = 0; a.ph_hi = REP_HI; a.li = 0;
    hipLaunchKernelGGL(skel_fwd, dim3(grid), dim3(NWAVES * 64), LDS_BYTES, stream, a);
    a.ph_lo = REP_LO; a.ph_hi = PH_N; a.li = 1;
    hipLaunchKernelGGL(skel_fwd, dim3(grid), dim3(NWAVES * 64), LDS_BYTES, stream, a);
#else
    a.ph_lo = 0; a.ph_hi = PH_N; a.li = 0;
    hipLaunchKernelGGL(skel_fwd, dim3(grid), dim3(NWAVES * 64), LDS_BYTES, stream, a);
#endif
}
```
